# Optimizing an MI355X kernel written in HIP

```python
import math
import jax, jax.numpy as jnp
from jax import lax
import numpy as np

D_MODEL = 2048
BATCH = 16
SEQ = 2048
DEPTH = 2
DEC_BATCH = 16
DEC_SEQ = 32
PAST_LEN = 2048

CHUNK = 64
Q_BLOCK = 128
N_MIXERS = 2
N_RG = (DEPTH + 1) // 2
N_ATTN = DEPTH // 2
D_RNN = D_MODEL
RG_BLOCKS = 16
RG_BLK = D_RNN // RG_BLOCKS
RG_CONV_W = 4
RG_C = 8.0
N_HEADS = 8
HEAD_DIM = D_MODEL // (2 * N_HEADS)
D_ATT = 2 * N_HEADS * HEAD_DIM
D_FF = 5632
FFN_CONV_W = 3
EPS = 1e-6
NEG_INF = -1e30

kernel_name = "hybrid_rglru_diffattn_convffn_stream_step"


def rms_norm(x, g):
    xf = x.astype(jnp.float32)
    y = xf * lax.rsqrt(jnp.mean(xf * xf, axis=-1, keepdims=True) + EPS)
    return (y * g.astype(jnp.float32)).astype(x.dtype)


def causal_dwconv(x_full, w, b, t):
    width = w.shape[0]
    out = b + x_full[:, 0:t] * w[0]
    for k in range(1, width):
        out = out + x_full[:, k:k + t] * w[k]
    return out


def linear_recurrence(a, b, h0):
    b = b.at[:, 0].add(a[:, 0] * h0)

    def combine(e1, e2):
        a1, b1 = e1
        a2, b2 = e2
        return a1 * a2, a2 * b1 + b2

    _, h = lax.associative_scan(combine, (a, b), axis=1)
    return h


def rglru_mixer(x, conv_hist, h0, w_in, conv_w, conv_b, gate_w, gate_b, log_lam, w_out):
    bsz, t, _ = x.shape
    u = x @ w_in
    gate_br, rec = u[..., :D_RNN], u[..., D_RNN:]
    y = jax.nn.gelu(gate_br)
    full = jnp.concatenate([conv_hist.astype(rec.dtype), rec], axis=1)
    xc = causal_dwconv(full, conv_w, conv_b, t)
    new_hist = full[:, -(RG_CONV_W - 1):]
    g = jnp.einsum('btnc,ncd->btnd', xc.reshape(bsz, t, RG_BLOCKS, RG_BLK), gate_w) + gate_b
    g = jax.nn.sigmoid(g.astype(jnp.float32))
    r = g[..., :RG_BLK].reshape(bsz, t, D_RNN)
    i = g[..., RG_BLK:].reshape(bsz, t, D_RNN)
    log_a = -RG_C * r * jax.nn.softplus(-log_lam.astype(jnp.float32))
    a = jnp.exp(log_a)
    mult = jnp.sqrt(-jnp.expm1(2.0 * log_a))
    b = mult * i * xc.astype(jnp.float32)
    h = linear_recurrence(a, b, h0.astype(jnp.float32))
    out = (h.astype(x.dtype) * y) @ w_out
    return out, new_hist, h[:, -1]


def diff_lambda(lam, lambda_init):
    lam = lam.astype(jnp.float32)
    return jnp.exp(jnp.sum(lam[0] * lam[1])) - jnp.exp(jnp.sum(lam[2] * lam[3])) + lambda_init


def diff_qkv(x, w_qkv):
    bsz, t, _ = x.shape
    qkv = x @ w_qkv
    q = qkv[..., :D_ATT].reshape(bsz, t, N_HEADS, 2, HEAD_DIM)
    k = qkv[..., D_ATT:2 * D_ATT].reshape(bsz, t, N_HEADS, 2, HEAD_DIM)
    v = qkv[..., 2 * D_ATT:].reshape(bsz, t, N_HEADS, 2 * HEAD_DIM)
    return q, k, v


def diff_attend(q, k, v, mask, lam):
    s = jnp.einsum('bqhjd,bkhjd->bhjqk', q, k).astype(jnp.float32) * (HEAD_DIM ** -0.5)
    if mask is not None:
        s = jnp.where(mask, s, NEG_INF)
    p = jax.nn.softmax(s, axis=-1)
    attn = p[:, :, 0] - lam * p[:, :, 1]
    return jnp.einsum('bhqk,bkhe->bqhe', attn.astype(v.dtype), v)


def diff_out(o, subln, lambda_init, w_out):
    bsz, t = o.shape[:2]
    o = rms_norm(o, subln) * (1.0 - lambda_init)
    return o.reshape(bsz, t, D_ATT) @ w_out


def diff_attn_prompt(x, w_qkv, lam_p, subln, w_out, lambda_init):
    bsz, t, _ = x.shape
    q, k, v = diff_qkv(x, w_qkv)
    lam = diff_lambda(lam_p, lambda_init)
    n_blk = t // Q_BLOCK
    q_blocks = jnp.moveaxis(q.reshape(bsz, n_blk, Q_BLOCK, N_HEADS, 2, HEAD_DIM), 1, 0)
    key_chunk = jnp.arange(t) // CHUNK

    def one_block(args):
        qb, blk = args
        q_chunk = (blk * Q_BLOCK + jnp.arange(Q_BLOCK)) // CHUNK
        mask = key_chunk[None, :] <= q_chunk[:, None]
        return diff_attend(qb, k, v, mask, lam)

    o = lax.map(one_block, (q_blocks, jnp.arange(n_blk)))
    o = jnp.moveaxis(o, 0, 1).reshape(bsz, t, N_HEADS, 2 * HEAD_DIM)
    return diff_out(o, subln, lambda_init, w_out), k.reshape(bsz, t, 2 * N_HEADS, HEAD_DIM), v


def diff_attn_sample(x, cache_k, cache_v, w_qkv, lam_p, subln, w_out, lambda_init):
    bsz, t, _ = x.shape
    past = cache_k.shape[1]
    q, k, v = diff_qkv(x, w_qkv)
    lam = diff_lambda(lam_p, lambda_init)
    k_all = jnp.concatenate(
        [cache_k.astype(k.dtype).reshape(bsz, past, N_HEADS, 2, HEAD_DIM), k], axis=1)
    v_all = jnp.concatenate([cache_v.astype(v.dtype), v], axis=1)
    o = diff_attend(q, k_all, v_all, None, lam)
    return diff_out(o, subln, lambda_init, w_out), k.reshape(bsz, t, 2 * N_HEADS, HEAD_DIM), v


def conv_ffn(x, hist, w_up, conv_w, conv_b, w_down):
    t = x.shape[1]
    u = x @ w_up
    full = jnp.concatenate([hist.astype(u.dtype), u], axis=1)
    c = causal_dwconv(full, conv_w, conv_b, t)
    h = jax.nn.gelu(c[..., :D_FF]) * c[..., D_FF:]
    return h @ w_down, full[:, -(FFN_CONV_W - 1):]


def setup_inputs(seed: int = 0) -> dict:
    key = jax.random.key(seed)
    ks = jax.random.split(key, 32)
    f32 = jnp.float32
    nrm = lambda k, shape, s: jax.random.normal(k, shape, f32) * s
    u_lam = jax.random.uniform(ks[13], (N_RG, D_RNN), f32, minval=0.9, maxval=0.999)
    return {
        "x_prompt": nrm(ks[0], (BATCH, SEQ, D_MODEL), 1.0),
        "x_sample": nrm(ks[1], (DEC_BATCH, DEC_SEQ, D_MODEL), 1.0),
        "state_rglru_conv": nrm(ks[2], (N_RG, DEC_BATCH, RG_CONV_W - 1, D_RNN), 1.0),
        "state_rglru_h": nrm(ks[3], (N_RG, DEC_BATCH, D_RNN), 0.5),
        "cache_attn_k": nrm(ks[4], (N_ATTN, DEC_BATCH, PAST_LEN, 2 * N_HEADS, HEAD_DIM), 1.0),
        "cache_attn_v": nrm(ks[5], (N_ATTN, DEC_BATCH, PAST_LEN, N_HEADS, 2 * HEAD_DIM), 1.0),
        "state_ffn_conv": nrm(ks[6], (DEPTH, DEC_BATCH, FFN_CONV_W - 1, 2 * D_FF), 1.0),
        "rg_norm": 1.0 + nrm(ks[7], (N_RG, D_MODEL), 0.02),
        "rg_w_in": nrm(ks[8], (N_RG, D_MODEL, 2 * D_RNN), D_MODEL ** -0.5),
        "rg_conv_w": nrm(ks[9], (N_RG, RG_CONV_W, D_RNN), RG_CONV_W ** -0.5),
        "rg_conv_b": nrm(ks[10], (N_RG, D_RNN), 0.01),
        "rg_gate_w": nrm(ks[11], (N_RG, RG_BLOCKS, RG_BLK, 2 * RG_BLK), RG_BLK ** -0.5),
        "rg_gate_b": nrm(ks[12], (N_RG, RG_BLOCKS, 2 * RG_BLK), 0.01),
        "rg_log_lambda": jnp.log(u_lam) - jnp.log1p(-u_lam),
        "rg_w_out": nrm(ks[14], (N_RG, D_RNN, D_MODEL), D_RNN ** -0.5),
        "at_norm": 1.0 + nrm(ks[15], (N_ATTN, D_MODEL), 0.02),
        "at_w_qkv": nrm(ks[16], (N_ATTN, D_MODEL, 3 * D_ATT), D_MODEL ** -0.5),
        "at_lambda": nrm(ks[17], (N_ATTN, 4, HEAD_DIM), 0.1),
        "at_subln": 1.0 + nrm(ks[18], (N_ATTN, 2 * HEAD_DIM), 0.02),
        "at_w_out": nrm(ks[19], (N_ATTN, D_ATT, D_MODEL), D_ATT ** -0.5),
        "ffn_norm": 1.0 + nrm(ks[20], (DEPTH, D_MODEL), 0.02),
        "ffn_w_up": nrm(ks[21], (DEPTH, D_MODEL, 2 * D_FF), D_MODEL ** -0.5),
        "ffn_conv_w": nrm(ks[22], (DEPTH, FFN_CONV_W, 2 * D_FF), FFN_CONV_W ** -0.5),
        "ffn_conv_b": nrm(ks[23], (DEPTH, 2 * D_FF), 0.01),
        "ffn_w_down": nrm(ks[24], (DEPTH, D_FF, D_MODEL), D_FF ** -0.5),
        "final_norm": 1.0 + nrm(ks[25], (D_MODEL,), 0.02),
    }


def reference(x_prompt, x_sample, state_rglru_conv, state_rglru_h, cache_attn_k, cache_attn_v,
              state_ffn_conv, rg_norm, rg_w_in, rg_conv_w, rg_conv_b, rg_gate_w, rg_gate_b,
              rg_log_lambda, rg_w_out, at_norm, at_w_qkv, at_lambda, at_subln, at_w_out,
              ffn_norm, ffn_w_up, ffn_conv_w, ffn_conv_b, ffn_w_down, final_norm):
    xp, xs = x_prompt, x_sample
    bp = xp.shape[0]
    p_rg_conv, p_rg_h, p_k, p_v, p_ffn = [], [], [], [], []
    s_rg_conv, s_rg_h, s_k, s_v, s_ffn = [], [], [], [], []
    for layer in range(DEPTH):
        j = layer // N_MIXERS
        if layer % N_MIXERS == 0:
            w = (rg_w_in[j], rg_conv_w[j], rg_conv_b[j], rg_gate_w[j], rg_gate_b[j],
                 rg_log_lambda[j], rg_w_out[j])
            zero_hist = jnp.zeros((bp, RG_CONV_W - 1, D_RNN), xp.dtype)
            zero_h = jnp.zeros((bp, D_RNN), jnp.float32)
            yp, cp, hp = rglru_mixer(rms_norm(xp, rg_norm[j]), zero_hist, zero_h, *w)
            ys, cs, hs = rglru_mixer(rms_norm(xs, rg_norm[j]), state_rglru_conv[j],
                                     state_rglru_h[j], *w)
            p_rg_conv.append(cp); p_rg_h.append(hp)
            s_rg_conv.append(cs); s_rg_h.append(hs)
        else:
            lambda_init = 0.8 - 0.6 * math.exp(-0.3 * layer)
            yp, kp, vp = diff_attn_prompt(rms_norm(xp, at_norm[j]), at_w_qkv[j], at_lambda[j],
                                          at_subln[j], at_w_out[j], lambda_init)
            ys, kn, vn = diff_attn_sample(rms_norm(xs, at_norm[j]), cache_attn_k[j], cache_attn_v[j],
                                          at_w_qkv[j], at_lambda[j], at_subln[j], at_w_out[j],
                                          lambda_init)
            p_k.append(kp); p_v.append(vp)
            s_k.append(kn); s_v.append(vn)
        xp = xp + yp
        xs = xs + ys
        zero_ffn = jnp.zeros((bp, FFN_CONV_W - 1, 2 * D_FF), xp.dtype)
        fp, fcp = conv_ffn(rms_norm(xp, ffn_norm[layer]), zero_ffn, ffn_w_up[layer],
                           ffn_conv_w[layer], ffn_conv_b[layer], ffn_w_down[layer])
        fs, fcs = conv_ffn(rms_norm(xs, ffn_norm[layer]), state_ffn_conv[layer], ffn_w_up[layer],
                           ffn_conv_w[layer], ffn_conv_b[layer], ffn_w_down[layer])
        p_ffn.append(fcp); s_ffn.append(fcs)
        xp = xp + fp
        xs = xs + fs
    y_prompt = rms_norm(xp, final_norm)
    y_sample = rms_norm(xs, final_norm)
    return (y_prompt, y_sample,
            jnp.stack(p_rg_conv), jnp.stack(p_rg_h), jnp.stack(p_k), jnp.stack(p_v), jnp.stack(p_ffn),
            jnp.stack(s_rg_conv), jnp.stack(s_rg_h), jnp.stack(s_k), jnp.stack(s_v), jnp.stack(s_ffn))
```

```cpp
#include <hip/hip_runtime.h>
#include <hip/hip_bf16.h>
#include <cstdio>
#include <cstdint>

namespace pg8 {
#define PG8_LAS __attribute__((address_space(3)))
typedef unsigned short bf16_t;
typedef short bf16x8 __attribute__((ext_vector_type(8)));
typedef float f32x4 __attribute__((ext_vector_type(4)));
typedef unsigned u32x4 __attribute__((ext_vector_type(4)));
constexpr int BM = 256, BK = 64, HALF = 128, HTB = HALF * BK * 2  , STAGE_BYTES = 8 * HTB, NXCD = 8, WGM = 4;

__host__ __device__ __forceinline__ int lds_byte(int r, int c) { const int st = (r >> 4) * 2 + (c >> 5), rr = r & 15, cc = c & 31, ob = rr * 64 + cc * 2; return st * 1024 + (ob ^ (((ob >> 9) & 1) << 5)); }
__host__ __device__ __forceinline__ void stage_rc(int b, int& R, int& C) { const int st = b / 1024, sb = b % 1024, swz = sb ^ (((sb >> 9) & 1) << 5); R = (st >> 1) * 16 + swz / 64; C = (st & 1) * 32 + (swz % 64) / 2; }
__host__ __device__ __forceinline__ int perm32(int rho) { const int n = rho >> 4, i = rho & 15; return 8 * (i >> 2) + 4 * n + (i & 3); }

struct Unit { int pm, pn, ko; };
struct Gemm { const bf16_t* A; const bf16_t* Bt; int M, N, K, ldk; };

struct StaticOrder {
    int nM, nN, nwg, G, c;
    __host__ __device__ void init(int M, int N, int G_, int c_) { nM = M / BM; nN = N / BM; nwg = nM * nN; G = G_; c = c_; }
    __host__ __device__ bool next(int i, Unit& u) const {
        const long L = (long)i * G + c; if (L >= nwg) return false;
        int wgid = (int)L; { const int q = nwg / NXCD, r = nwg % NXCD, xcd = wgid % NXCD, off = wgid / NXCD; wgid = (xcd < r ? xcd * (q + 1) : r * (q + 1) + (xcd - r) * q) + off; }
        const int nig = WGM * nN, gid = wgid / nig, fm = gid * WGM, gsz = (nM - fm) < WGM ? (nM - fm) : WGM;
        u.pm = fm + ((wgid % nig) % gsz); u.pn = (wgid % nig) / gsz; u.ko = 0; return true;
    }
    __device__ __forceinline__ void a_ready(const Unit&) const {}
    __device__ __forceinline__ void done(const Unit&) const {}
};
struct SplitOrder {
    int pm0, nN, f, kc, total, G, c;
    __host__ __device__ void init(int pm0_, int N, int f_, int kc_, int G_, int c_) { pm0 = pm0_; nN = N / BM; f = f_; kc = kc_; total = 2 * nN * f; G = G_; c = c_; }
    __host__ __device__ bool next(int i, Unit& u) const { const int L = i * G + c; if (L >= total) return false; const int ks = L % f, r = L / f; u.pn = r % nN; u.pm = pm0 + r / nN; u.ko = ks * kc; return true; }
    __device__ __forceinline__ void a_ready(const Unit&) const {}
    __device__ __forceinline__ void done(const Unit&) const {}
};

template <class Epi, class Sched, bool ALIGN_EPI = false, bool SP2 = false>
__device__ __forceinline__ void gemm_phase(PG8_LAS unsigned char* lds, const Gemm g, const Sched& S, const Epi& E) {
    int tid = threadIdx.x; asm volatile("" : "+v"(tid));
    const int wid = __builtin_amdgcn_readfirstlane(tid >> 6), lane = tid & 63, wr = wid >> 2, wc = wid & 3, fr = lane & 15, fq = lane >> 4;
    const int K = g.ldk, nt = g.K / BK;
    unsigned voffA[2], voffB[2];
#pragma unroll
    for (int i = 0; i < 2; ++i) { int R, C; stage_rc(tid * 16 + i * 8192, R, C); const int Rb = Epi::PERM ? ((R & ~31) + perm32(R & 31)) : R;
        voffA[i] = (unsigned)(R * K + C) * 2u; voffB[i] = (unsigned)(Rb * K + C) * 2u; }
    const size_t kstep = (size_t)(BK * 2);
    const size_t hstep = (size_t)HALF * K * 2;
    const size_t tstep = 2 * hstep;
    const unsigned ldsw = (unsigned)wid * 1024u;
    const int aoff = lds_byte(wr * 64 + fr, fq * 8), boff = lds_byte(wc * 32 + fr, fq * 8);
#define PG8_SA(b, h) (((b) * 2 + (h)) * HTB)
#define PG8_SB(b, h) ((4 + (b) * 2 + (h)) * HTB)
#define PG8_STAGE(bufoff, gbase, voff) do { _Pragma("unroll") for (int _i = 0; _i < 2; ++_i) \
        __builtin_amdgcn_global_load_lds((const unsigned*)((const char*)(gbase) + (voff)[_i]), (PG8_LAS unsigned*)(lds + (bufoff) + ldsw + _i * 8192), 16, 0, 0); } while (0)
#define PG8_LDA(dst, b, h) do { _Pragma("unroll") for (int m = 0; m < 4; ++m) _Pragma("unroll") for (int k = 0; k < 2; ++k) dst[m][k] = *(const PG8_LAS bf16x8*)(lds + PG8_SA(b, h) + aoff + m * 2048 + k * 1024); } while (0)
#define PG8_LDB(dst, b, h) do { _Pragma("unroll") for (int n = 0; n < 2; ++n) _Pragma("unroll") for (int k = 0; k < 2; ++k) dst[n][k] = *(const PG8_LAS bf16x8*)(lds + PG8_SB(b, h) + boff + n * 2048 + k * 1024); } while (0)
#define PG8_MMA(ai, bj, At, Bt) do { __builtin_amdgcn_s_setprio(1); _Pragma("unroll") for (int m = 0; m < 4; ++m) _Pragma("unroll") for (int n = 0; n < 2; ++n) _Pragma("unroll") for (int k = 0; k < 2; ++k) \
        acc[ai][bj][m][n] = __builtin_amdgcn_mfma_f32_16x16x32_bf16(Bt[n][k], At[m][k], acc[ai][bj][m][n], 0, 0, 0); __builtin_amdgcn_s_setprio(0); } while (0)
#define PG8_WAIT_V(n) asm volatile("s_waitcnt vmcnt(" #n ")" ::: "memory")
#define PG8_WAIT_L(n) asm volatile("s_waitcnt lgkmcnt(" #n ")" ::: "memory")
#define PG8_BAR __builtin_amdgcn_s_barrier()
#define PG8_SCHED __builtin_amdgcn_sched_barrier(0)
    Unit cur, nxt; int ui = 0;
    if (!S.next(0, cur)) return;
    f32x4 acc[2][2][4][2];
#pragma unroll
    for (int a = 0; a < 2; ++a)
#pragma unroll
        for (int b = 0; b < 2; ++b)
#pragma unroll
            for (int m = 0; m < 4; ++m)
#pragma unroll
                for (int n = 0; n < 2; ++n) acc[a][b][m][n] = (f32x4){0.f, 0.f, 0.f, 0.f};
    bf16x8 At[4][2], B0[2][2], B1[2][2];
    const char* cA = (const char*)g.A + (size_t)cur.pm * tstep + (size_t)cur.ko * 2; const char* cB = (const char*)g.Bt + (size_t)cur.pn * tstep + (size_t)cur.ko * 2;
    S.a_ready(cur);
    if constexpr (SP2) {
        PG8_STAGE(PG8_SB(0, 0), cB, voffB); PG8_STAGE(PG8_SB(0, 1), cB + hstep, voffB); PG8_STAGE(PG8_SA(0, 0), cA, voffA); PG8_STAGE(PG8_SA(0, 1), cA + hstep, voffA);
        if (wr == 1) PG8_BAR;
        PG8_WAIT_V(2); PG8_BAR;
        PG8_STAGE(PG8_SB(1, 0), cB + kstep, voffB); PG8_STAGE(PG8_SA(1, 0), cA + kstep, voffA); PG8_STAGE(PG8_SB(1, 1), cB + hstep + kstep, voffB);
        PG8_WAIT_V(6); PG8_BAR;
    } else {
        PG8_STAGE(PG8_SB(0, 0), cB, voffB); PG8_STAGE(PG8_SA(0, 0), cA, voffA); PG8_STAGE(PG8_SB(0, 1), cB + hstep, voffB); PG8_STAGE(PG8_SA(0, 1), cA + hstep, voffA);
        if (wr == 1) PG8_BAR;
        PG8_WAIT_V(4); PG8_BAR;
        PG8_STAGE(PG8_SB(1, 0), cB + kstep, voffB); PG8_STAGE(PG8_SA(1, 0), cA + kstep, voffA); PG8_STAGE(PG8_SB(1, 1), cB + hstep + kstep, voffB);
        PG8_WAIT_V(6); PG8_BAR;
    }
    for (;;) {
        const bool has_next = S.next(ui + 1, nxt);
        PG8_LAS unsigned char* const ep = lds + 8 * HTB + (ui & 1) * 5120;
        if constexpr (Epi::PRE) E.prefetch(ep, cur, wid, lane);
        const char* nA = has_next ? (const char*)g.A + (size_t)nxt.pm * tstep + (size_t)nxt.ko * 2 : cA; const char* nB = has_next ? (const char*)g.Bt + (size_t)nxt.pn * tstep + (size_t)nxt.ko * 2 : cB;
        for (int t = 0; t < nt; t += 2) {
            const bool last = (t == nt - 2);
            const char* a1 = cA + (size_t)(t + 1) * kstep;
            const char* a2 = last ? nA : cA + (size_t)(t + 2) * kstep; const char* b2 = last ? nB : cB + (size_t)(t + 2) * kstep;
            const char* a3 = a2 + kstep; const char* b3 = b2 + kstep;
            if (last && has_next) S.a_ready(nxt);
            if constexpr (SP2) {
            PG8_LDB(B0, 0, 0); PG8_LDB(B1, 0, 1); PG8_SCHED; PG8_LDA(At, 0, 0); PG8_STAGE(PG8_SA(1, 1), a1 + hstep, voffA);
            PG8_WAIT_V(8); PG8_WAIT_L(0); PG8_BAR; PG8_MMA(0, 0, At, B0); PG8_MMA(0, 1, At, B1); PG8_BAR; PG8_SCHED;
            PG8_LDA(At, 0, 1); PG8_STAGE(PG8_SB(0, 0), b2, voffB); PG8_STAGE(PG8_SB(0, 1), b2 + hstep, voffB); PG8_STAGE(PG8_SA(0, 0), a2, voffA);
            PG8_WAIT_V(8); PG8_WAIT_L(0); PG8_BAR; PG8_MMA(1, 0, At, B0); PG8_MMA(1, 1, At, B1); PG8_BAR; PG8_SCHED;
            PG8_LDB(B0, 1, 0); PG8_LDB(B1, 1, 1); PG8_SCHED; PG8_LDA(At, 1, 0); PG8_STAGE(PG8_SA(0, 1), a2 + hstep, voffA);
            PG8_WAIT_V(8); PG8_WAIT_L(0); PG8_BAR; PG8_MMA(0, 0, At, B0); PG8_MMA(0, 1, At, B1); PG8_BAR; PG8_SCHED;
            PG8_LDA(At, 1, 1); PG8_STAGE(PG8_SB(1, 0), b3, voffB); PG8_STAGE(PG8_SB(1, 1), b3 + hstep, voffB); PG8_STAGE(PG8_SA(1, 0), a3, voffA);
            PG8_WAIT_V(8); PG8_WAIT_L(0); PG8_BAR; PG8_MMA(1, 0, At, B0); PG8_MMA(1, 1, At, B1); PG8_BAR; PG8_SCHED;
            } else {
            PG8_LDB(B0, 0, 0); PG8_SCHED; PG8_LDA(At, 0, 0); PG8_STAGE(PG8_SA(1, 1), a1 + hstep, voffA);
            PG8_WAIT_L(8); PG8_BAR; PG8_WAIT_L(0); PG8_MMA(0, 0, At, B0); PG8_BAR; PG8_SCHED;
            PG8_LDB(B1, 0, 1); PG8_STAGE(PG8_SB(0, 0), b2, voffB);
            PG8_BAR; PG8_WAIT_L(0); PG8_MMA(0, 1, At, B1); PG8_BAR;
            PG8_LDA(At, 0, 1); PG8_STAGE(PG8_SA(0, 0), a2, voffA);
            PG8_BAR; PG8_WAIT_L(0); PG8_MMA(1, 0, At, B0); PG8_BAR; PG8_SCHED;
            PG8_STAGE(PG8_SB(0, 1), b2 + hstep, voffB);
            PG8_WAIT_V(6); PG8_BAR; PG8_MMA(1, 1, At, B1); PG8_BAR;
            PG8_LDB(B0, 1, 0); PG8_SCHED; PG8_LDA(At, 1, 0); PG8_STAGE(PG8_SA(0, 1), a2 + hstep, voffA);
            PG8_WAIT_L(8); PG8_BAR; PG8_WAIT_L(0); PG8_MMA(0, 0, At, B0); PG8_BAR; PG8_SCHED;
            PG8_LDB(B1, 1, 1); PG8_STAGE(PG8_SB(1, 0), b3, voffB);
            PG8_BAR; PG8_WAIT_L(0); PG8_MMA(0, 1, At, B1); PG8_BAR;
            PG8_LDA(At, 1, 1); PG8_STAGE(PG8_SA(1, 0), a3, voffA);
            PG8_BAR; PG8_WAIT_L(0); PG8_MMA(1, 0, At, B0); PG8_BAR; PG8_SCHED;
            PG8_STAGE(PG8_SB(1, 1), b3 + hstep, voffB);
            PG8_WAIT_V(6); PG8_BAR; PG8_MMA(1, 1, At, B1); PG8_BAR;
            }
        }
        if constexpr (ALIGN_EPI) { if (wr == 0) PG8_BAR; }
        E(acc, cur, wr, wc, fr, fq, ep); S.done(cur);
        if (!has_next) break;
#pragma unroll
        for (int a = 0; a < 2; ++a)
#pragma unroll
            for (int b = 0; b < 2; ++b)
#pragma unroll
                for (int m = 0; m < 4; ++m)
#pragma unroll
                    for (int n = 0; n < 2; ++n) acc[a][b][m][n] = (f32x4){0.f, 0.f, 0.f, 0.f};
        cur = nxt; cA = nA; cB = nB; ++ui;
        if constexpr (ALIGN_EPI) { if (wr == 1) PG8_BAR; }
    }
    PG8_WAIT_V(0);
    if constexpr (!ALIGN_EPI) { if (wr == 0) PG8_BAR; }
    PG8_BAR;
#undef PG8_SA
#undef PG8_SB
#undef PG8_STAGE
#undef PG8_LDA
#undef PG8_LDB
#undef PG8_MMA
#undef PG8_WAIT_V
#undef PG8_WAIT_L
#undef PG8_BAR
#undef PG8_SCHED
}
}

#ifndef PG8_SP2
#define PG8_SP2 true
#endif
#ifndef PG8_ALIGN
#define PG8_ALIGN true
#endif

constexpr int DM = 2048, NBATCH = 16, SEQ = 2048, DECB = 16, DECS = 32, PAST = 2048;
constexpr int MP = NBATCH * SEQ, MS = DECB * DECS, MT = MP + MS;
constexpr int DFF = 5632, NUP = 2 * DFF, NQKV = 3 * DM;
constexpr int NWAVES = 8;
constexpr float EPS = 1e-6f;
constexpr float LAMBDA_INIT = 0.35550906759f;
constexpr size_t O_Y = 0;
constexpr size_t O_RGC_P = (size_t)MT * DM;
constexpr size_t O_RGH_P = O_RGC_P + 16 * 3 * 2048;
constexpr size_t O_K_P = O_RGH_P + 16 * 2048;
constexpr size_t O_V_P = O_K_P + (size_t)MP * DM;
constexpr size_t O_FFN_P = O_V_P + (size_t)MP * DM;
constexpr size_t O_RGC_S = O_FFN_P + 2 * 16 * 2 * NUP;
constexpr size_t O_RGH_S = O_RGC_S + 16 * 3 * 2048;
constexpr size_t O_K_S = O_RGH_S + 16 * 2048;
constexpr size_t O_V_S = O_K_S + (size_t)MS * DM;
constexpr size_t O_FFN_S = O_V_S + (size_t)MS * DM;
constexpr size_t O_END = O_FFN_S + 2 * 16 * 2 * NUP;
static_assert(O_END == 206176256ull && O_V_P - O_K_P == (size_t)MP * DM && O_V_S - O_K_S == (size_t)MS * DM, "d_out size");

constexpr size_t MiB = 1u << 20;
constexpr size_t WS_CTL = 0, CTL_ZERO_BYTES = 1 * MiB;
constexpr size_t WS_WIN = 2 * MiB, WS_RGO = 18 * MiB, WS_QKV = 26 * MiB, WS_ATO = 50 * MiB, WS_UP0 = 58 * MiB, WS_UP1 = 102 * MiB, WS_DN0 = 146 * MiB, WS_DN1 = 168 * MiB, WS_GW = 190 * MiB;
constexpr size_t WS_SS = 192 * MiB, SS_STRIDE = 5 * MiB;
constexpr size_t WS_XB = 218 * MiB;
constexpr size_t WS_BIG = 348 * MiB;
constexpr size_t WS_U = WS_BIG, WS_HY = WS_BIG + 260 * MiB;
constexpr size_t WS_H = WS_BIG, WS_UE = WS_BIG + 358 * MiB;
constexpr size_t WS_Q = WS_BIG, WS_K = WS_BIG + 130 * MiB, WS_V = WS_BIG + 260 * MiB, WS_OB = WS_BIG + 390 * MiB, WS_ST = WS_BIG + 520 * MiB;
constexpr size_t WS_SLAB = WS_BIG + 600 * MiB;
constexpr size_t WS_END = WS_SLAB + 48 * MiB;
constexpr int NCB = 528;
constexpr int ST_PER_LANE = 144;
static_assert((size_t)MT * DFF * 2 <= 358 * MiB && (size_t)NCB * 4 * NUP * 4 <= 100 * MiB && (size_t)256 * 512 * ST_PER_LANE * 4 <= 80 * MiB, "ws map");
constexpr size_t RS_OFF = (size_t)MT * 32;
static_assert((size_t)MT * 33 * 4 <= SS_STRIDE, "rs behind ss");
static_assert((size_t)MT * 32 * 4 <= SS_STRIDE && WS_SS + 5 * SS_STRIDE <= WS_XB && WS_XB + (size_t)MT * DM * 2 <= WS_BIG, "ws map 2");
constexpr int CW_BAR = 4096, CW_ATTNQ = 16384;

constexpr int RING_OFF = 0, RING_BYTES = 131072;
constexpr int LDS_BYTES = 147456;
constexpr int LDSCTL_OFF = LDS_BYTES - 512, MISC_OFF = LDSCTL_OFF + 320;

#define GAS __attribute__((address_space(1)))
#define LAS __attribute__((address_space(3)))
typedef unsigned short bf16;
typedef unsigned v4u __attribute__((ext_vector_type(4)));
typedef unsigned v2u __attribute__((ext_vector_type(2)));
typedef float f32x4 __attribute__((ext_vector_type(4)));
typedef float f32x2 __attribute__((ext_vector_type(2)));
typedef float f32x16 __attribute__((ext_vector_type(16)));
typedef short bf16x8 __attribute__((ext_vector_type(8)));
typedef short s16x4 __attribute__((ext_vector_type(4)));
#define LDS_WAIT() asm volatile("s_waitcnt lgkmcnt(0)" ::: "memory")
#define VM_WAIT() asm volatile("s_waitcnt vmcnt(0)" ::: "memory")
__device__ __forceinline__ unsigned cvtpk(float lo, float hi) { unsigned r; asm volatile("v_cvt_pk_bf16_f32 %0, %1, %2" : "=v"(r) : "v"(lo), "v"(hi)); return r; }
__device__ __forceinline__ float bf2f(unsigned short h) { return __builtin_bit_cast(float, (unsigned)h << 16); }
__device__ __forceinline__ bf16x8 pack8(f32x4 a, f32x4 b) { v4u w = {cvtpk(a[0], a[1]), cvtpk(a[2], a[3]), cvtpk(b[0], b[1]), cvtpk(b[2], b[3])}; return __builtin_bit_cast(bf16x8, w); }
__device__ __forceinline__ float wave_sum(float v) {
#pragma unroll
    for (int o = 1; o < 64; o <<= 1) v += __shfl_xor(v, o);
    return v;
}
__device__ __forceinline__ float gelu_tanh(float x) {
    const float z = x * (0.7978845608f + 0.0356774081f * x * x);
    const float e = __builtin_amdgcn_exp2f(z * -2.885390082f);
    return x * __builtin_amdgcn_rcpf(1.0f + e);
}
__device__ __forceinline__ float sigmoidf_(float x) { return __builtin_amdgcn_rcpf(1.0f + __builtin_amdgcn_exp2f(x * -1.4426950409f)); }
#define DPP_F(oldv, src, ctrl, bc) __builtin_bit_cast(float, __builtin_amdgcn_update_dpp(__builtin_bit_cast(int, (float)(oldv)), __builtin_bit_cast(int, (float)(src)), (ctrl), 0xf, 0xf, (bc)))

__device__ __forceinline__ int opaque_tid() { int t = threadIdx.x; asm volatile("" : "+v"(t)); return t; }
#define XB_TMO      128
#define XB_XCNT(j)  (256  + 64 * (j))
#define XB_XSUB(j)  (1280 + 64 * (j))
#define XB_XGEN(j)  (2304 + 64 * (j))
#define XB_TOP      3328
#define XB_TOPGEN   3392
#define XCD_BAR_WORDS 3456
#define XB_SPIN_CAP (1u << 18)

__device__ __forceinline__ unsigned xb_ld(unsigned* p)              { return __hip_atomic_load(p, __ATOMIC_RELAXED, __HIP_MEMORY_SCOPE_AGENT); }
__device__ __forceinline__ unsigned xb_add(unsigned* p, unsigned v) { return __hip_atomic_fetch_add(p, v, __ATOMIC_RELAXED, __HIP_MEMORY_SCOPE_AGENT); }
__device__ __forceinline__ unsigned xb_xcc_id() { return (unsigned)__builtin_amdgcn_s_getreg((3 << 11) | 20) & 0xFu; }
#define XB_SPIN(cond, bar) do { unsigned _sp = 0; while (cond) { __builtin_amdgcn_s_sleep(1); \
    if ((++_sp & 255u) == 0u) { if (xb_ld(&(bar)[XB_TMO])) break; if (_sp > XB_SPIN_CAP) { atomicAdd(&(bar)[XB_TMO], 1u); break; } } } } while (0)

struct XcdBarrier {
    unsigned* bar; unsigned x;
    volatile LAS unsigned* st;
};
__device__ __forceinline__ XcdBarrier xcd_barrier_post(unsigned* bar, volatile LAS unsigned* st) {
    XcdBarrier b; b.bar = bar; b.x = xb_xcc_id(); b.st = st;
    if (threadIdx.x == 0) (void)xb_add(&bar[XB_XCNT(b.x)], 1u);
    return b;
}
__device__ __forceinline__ void xcd_barrier_complete(unsigned* bar, unsigned x, unsigned& nloc, unsigned& nx) {
    const unsigned G = gridDim.x * gridDim.y * gridDim.z;
    unsigned sum, cnt, mine, sp = 0u;
    for (;;) {
        sum = 0u; cnt = 0u; mine = 0u;
#pragma unroll
        for (unsigned j = 0; j < 16; ++j) { const unsigned c = xb_ld(&bar[XB_XCNT(j)]); sum += c; cnt += (c > 0u) ? 1u : 0u; mine = (j == x) ? c : mine; }
        if (sum == G) break;
        __builtin_amdgcn_s_sleep(1);
        if ((++sp & 255u) == 0u) { if (xb_ld(&bar[XB_TMO])) break; if (sp > XB_SPIN_CAP) { atomicAdd(&bar[XB_TMO], 1u); break; } }
    }
    nloc = mine > 0u ? mine : 1u; nx = cnt > 0u ? cnt : 1u;
}
__device__ __forceinline__ void xcd_barrier(const XcdBarrier& b) {
    asm volatile("s_waitcnt vmcnt(0)" ::: "memory");
    __syncthreads();
    if (threadIdx.x == 0) {
        unsigned* bar = b.bar;
        __builtin_amdgcn_s_waitcnt(0);
        unsigned nloc = b.st[0], nx = b.st[1];
        if (nloc == 0u) { xcd_barrier_complete(bar, b.x, nloc, nx); b.st[0] = nloc; b.st[1] = nx; }
        const unsigned old = xb_add(&bar[XB_XSUB(b.x)], 1u);
        const unsigned gen = old / nloc;
        if (old + 1u == (gen + 1u) * nloc) {
            __builtin_amdgcn_fence(__ATOMIC_RELEASE, "agent");
            asm volatile("s_waitcnt vmcnt(0)" ::: "memory");
            const unsigned og = xb_add(&bar[XB_TOP], 1u);
            const unsigned tg = og / nx;
            if (og + 1u == (tg + 1u) * nx) xb_add(&bar[XB_TOPGEN], 1u);
            else XB_SPIN(xb_ld(&bar[XB_TOPGEN]) == tg, bar);
            __builtin_amdgcn_fence(__ATOMIC_ACQUIRE, "agent");
            xb_add(&bar[XB_XGEN(b.x)], 1u);
            asm volatile("s_waitcnt vmcnt(0)" ::: "memory");
        } else {
            XB_SPIN(xb_ld(&bar[XB_XGEN(b.x)]) == gen, bar);
            __builtin_amdgcn_fence(__ATOMIC_ACQUIRE, "agent");
            asm volatile("s_waitcnt vmcnt(0)" ::: "memory");
        }
    }
    __syncthreads();
}

struct Args { const float* in[26]; float* out; unsigned char* ws; };
enum { I_XP = 0, I_XS, I_SRGC, I_SRGH, I_CK, I_CV, I_SFFN, I_RGNORM, I_RGWIN, I_RGCW, I_RGCB, I_RGGW, I_RGGB, I_RGLL, I_RGWOUT, I_ATNORM, I_ATWQKV, I_ATLAM, I_ATSUBLN, I_ATWOUT,
       I_FFNNORM, I_FFNWUP, I_FFNCW, I_FFNCB, I_FFNWDN, I_FINNORM };

__device__ __forceinline__ void p0_transpose_item(const float* W, const float* gain, int K, int N, bf16* WT, int mode, LAS float* scr, int item, int lane) {
    const int nblk = N / 64, kb = item / nblk, nb = item % nblk, k0 = 64 * kb, n0 = 64 * nb;
    const int c = lane & 7;
    f32x4 g0 = {1.f, 1.f, 1.f, 1.f}, g1 = g0;
    if (gain) { g0 = *(const f32x4*)(gain + k0 + 8 * c); g1 = *(const f32x4*)(gain + k0 + 8 * c + 4); }
    float w[64];
    const float* wp = W + (size_t)k0 * N + n0 + lane;
#pragma unroll
    for (int i = 0; i < 64; ++i) w[i] = wp[(size_t)i * N];
#pragma unroll
    for (int i = 0; i < 64; ++i) scr[i * 65 + lane] = w[i];
    LDS_WAIT(); asm volatile("" ::: "memory");
    int r0 = n0;
    if (mode == 1) { const int j = n0 < DFF ? n0 : n0 - DFF; r0 = 256 * (j >> 7) + (n0 < DFF ? 0 : 128) + (j & 127); }
#pragma unroll
    for (int j = 0; j < 8; ++j) { const int n = (lane >> 3) + 8 * j; const LAS float* s = scr + (8 * c) * 65 + n;
        v4u o; o.x = cvtpk(s[0 * 65] * g0[0], s[1 * 65] * g0[1]); o.y = cvtpk(s[2 * 65] * g0[2], s[3 * 65] * g0[3]); o.z = cvtpk(s[4 * 65] * g1[0], s[5 * 65] * g1[1]); o.w = cvtpk(s[6 * 65] * g1[2], s[7 * 65] * g1[3]);
        *(GAS v4u*)(WT + (size_t)(r0 + n) * K + k0 + 8 * c) = o; }
    LDS_WAIT(); asm volatile("" ::: "memory");
}

__device__ __forceinline__ float rstd_from_ss(const float* ss, int row, int fq) {
    const f32x4* p = (const f32x4*)(ss + (size_t)row * 32 + 8 * fq);
    const f32x4 a = p[0], b = p[1];
    float s = ((a[0] + a[1]) + (a[2] + a[3])) + ((b[0] + b[1]) + (b[2] + b[3]));
    s += __shfl_xor(s, 16); s += __shfl_xor(s, 32);
    return __builtin_amdgcn_rsqf(s * (1.0f / DM) + EPS);
}

__device__ __forceinline__ GAS char* uni_f(const void* p) { const unsigned long long b = (unsigned long long)p; const unsigned lo = __builtin_amdgcn_readfirstlane((unsigned)b), hi = __builtin_amdgcn_readfirstlane((unsigned)(b >> 32)); return (GAS char*)(((unsigned long long)hi << 32) | lo); }
typedef f32x4 AccT[2][2][4][2];
struct EpiWin {
    static constexpr bool PERM = true, PRE = true; static constexpr int NST = 16;
    bf16* U; const float* rs;
    __device__ __forceinline__ void prefetch(LAS unsigned char* ep, const pg8::Unit& u, int wid, int lane) const {
        if (wid < 4) __builtin_amdgcn_global_load_lds((const unsigned*)(rs + u.pm * 256 + wid * 64 + lane), (LAS unsigned*)(ep + 4096 + wid * 256), 4, 0, 0);
    }
    __device__ __forceinline__ void operator()(AccT& acc, const pg8::Unit& u, int wr, int wc, int fr_in, int fq_in, LAS unsigned char* ep) const {
        int fr = fr_in, fq = fq_in; asm volatile("" : "+v"(fr), "+v"(fq));
        const int row0 = u.pm * 256 + wr * 64 + fr, col0 = u.pn * 256 + wc * 32 + 8 * fq; const bool act = u.pn < 8;
        const LAS char* rsb = (const LAS char*)ep + 4096 + (wr * 64 + fr) * 4;
        float r[2][4];
#pragma unroll
        for (int ai = 0; ai < 2; ++ai)
#pragma unroll
            for (int m = 0; m < 4; ++m) r[ai][m] = *(const LAS float*)(rsb + (ai * 128 + m * 16) * 4);
#pragma unroll
        for (int ai = 0; ai < 2; ++ai)
#pragma unroll
            for (int m = 0; m < 4; ++m) { const int row = row0 + ai * 128 + m * 16; const float rs_ = r[ai][m];
#pragma unroll
                for (int bj = 0; bj < 2; ++bj) { f32x4 v0 = acc[ai][bj][m][0] * rs_, v1 = acc[ai][bj][m][1] * rs_;
                    if (act) {
#pragma unroll
                        for (int i = 0; i < 4; ++i) { v0[i] = gelu_tanh(v0[i]); v1[i] = gelu_tanh(v1[i]); } }
                    v4u w; w.x = cvtpk(v0[0], v0[1]); w.y = cvtpk(v0[2], v0[3]); w.z = cvtpk(v1[0], v1[1]); w.w = cvtpk(v1[2], v1[3]);
                    *(v4u*)(U + (size_t)row * 4096 + col0 + bj * 128) = w; } }
    }
};
struct EpiResid {
    static constexpr bool PERM = true, PRE = false; static constexpr int NST = 48;
    const float* baseP; const float* baseS; float* X; bf16* XB; float* ssout;
    __device__ __forceinline__ void operator()(AccT& acc, const pg8::Unit& u, int wr, int wc, int fr_in, int fq_in, LAS unsigned char*) const {
        int fr = fr_in, fq = fq_in; asm volatile("" : "+v"(fr), "+v"(fq));
        const int row0 = u.pm * 256 + wr * 64 + fr, col0 = u.pn * 256 + wc * 32 + 8 * fq;
        const float* bp0 = (u.pm < 128) ? baseP + (size_t)row0 * DM + col0 : baseS + (size_t)(row0 - MP) * DM + col0;
        f32x4 b[4][2][2];
#define RESID_LD(slot, g) { const float* q_ = bp0 + (size_t)(((g) >> 2) * 128 + ((g) & 3) * 16) * DM; \
            b[slot][0][0] = *(const f32x4*)(q_); b[slot][0][1] = *(const f32x4*)(q_ + 4); b[slot][1][0] = *(const f32x4*)(q_ + 128); b[slot][1][1] = *(const f32x4*)(q_ + 132); }
        RESID_LD(0, 0); RESID_LD(1, 1); RESID_LD(2, 2); RESID_LD(3, 3);
#pragma unroll
        for (int g = 0; g < 8; ++g) { const int ai = g >> 2, m = g & 3, row = row0 + ai * 128 + m * 16; float q = 0.f;
            f32x4 o[2][2];
#pragma unroll
            for (int bj = 0; bj < 2; ++bj) { o[bj][0] = b[g & 3][bj][0] + acc[ai][bj][m][0]; o[bj][1] = b[g & 3][bj][1] + acc[ai][bj][m][1]; }
            if (g + 4 < 8) RESID_LD(g & 3, g + 4);
            asm volatile("" ::: "memory");
#pragma unroll
            for (int bj = 0; bj < 2; ++bj) { const int col = col0 + bj * 128; const f32x4 o0 = o[bj][0], o1 = o[bj][1];
                *(f32x4*)(X + (size_t)row * DM + col) = o0; *(f32x4*)(X + (size_t)row * DM + col + 4) = o1;
                v4u w; w.x = cvtpk(o0[0], o0[1]); w.y = cvtpk(o0[2], o0[3]); w.z = cvtpk(o1[0], o1[1]); w.w = cvtpk(o1[2], o1[3]);
                *(v4u*)(XB + (size_t)row * DM + col) = w;
                q += (o0[0] * o0[0] + o0[1] * o0[1]) + (o0[2] * o0[2] + o0[3] * o0[3]) + (o1[0] * o1[0] + o1[1] * o1[1]) + (o1[2] * o1[2] + o1[3] * o1[3]); }
            q += __shfl_xor(q, 16); q += __shfl_xor(q, 32);
            if (fq == 0) ssout[(size_t)row * 32 + 4 * u.pn + wc] = q; }
#undef RESID_LD
    }
};
struct EpiSlab {
    static constexpr bool PERM = true, PRE = false; static constexpr int NST = 32;
    float* slab; int kc;
    __device__ __forceinline__ void operator()(AccT& acc, const pg8::Unit& u, int wr, int wc, int fr_in, int fq_in, LAS unsigned char*) const {
        int fr = fr_in, fq = fq_in; asm volatile("" : "+v"(fr), "+v"(fq));
        const int ks = u.ko / kc;
        GAS char* base = uni_f(slab + ((size_t)ks * MS + (size_t)(u.pm - 128) * 256 + wr * 64) * DM + u.pn * 256 + wc * 32);
        const unsigned lo = (unsigned)(fr * DM + 8 * fq) * 4u;
#pragma unroll
        for (int ai = 0; ai < 2; ++ai)
#pragma unroll
            for (int m = 0; m < 4; ++m)
#pragma unroll
                for (int bj = 0; bj < 2; ++bj) { GAS char* p = base + lo + (unsigned)((ai * 128 + m * 16) * DM + bj * 128) * 4u;
                    *(GAS f32x4*)p = acc[ai][bj][m][0]; *(GAS f32x4*)(p + 16) = acc[ai][bj][m][1]; }
    }
};
struct EpiQkv {
    static constexpr bool PERM = true, PRE = true; static constexpr int NST = 16;
    bf16* Qb; bf16* Kb; bf16* Vb; float* out; const float* rs;
    __device__ __forceinline__ void prefetch(LAS unsigned char* ep, const pg8::Unit& u, int wid, int lane) const {
        if (wid < 4) __builtin_amdgcn_global_load_lds((const unsigned*)(rs + u.pm * 256 + wid * 64 + lane), (LAS unsigned*)(ep + 4096 + wid * 256), 4, 0, 0);
    }
    __device__ __forceinline__ void operator()(AccT& acc, const pg8::Unit& u, int wr, int wc, int fr_in, int fq_in, LAS unsigned char* ep) const {
        int fr = fr_in, fq = fq_in; asm volatile("" : "+v"(fr), "+v"(fq));
        const int t = u.pn >> 3; const int rl0 = wr * 64 + fr, col0 = (u.pn & 7) * 256 + wc * 32 + 8 * fq;
        bf16* dst = Qb + (size_t)t * ((WS_K - WS_Q) / 2) + (size_t)u.pm * 256 * DM;
        const size_t tk = (size_t)(t == 2 ? 1 : 0);
        float* fo = (u.pm < 128) ? out + O_K_P + tk * ((size_t)MP * DM) + (size_t)u.pm * 256 * DM : out + O_K_S + tk * ((size_t)MS * DM) + (size_t)(u.pm - 128) * 256 * DM;
        const LAS char* rsb = (const LAS char*)ep + 4096 + (wr * 64 + fr) * 4;
        float r[2][4];
#pragma unroll
        for (int ai = 0; ai < 2; ++ai)
#pragma unroll
            for (int m = 0; m < 4; ++m) r[ai][m] = *(const LAS float*)(rsb + (ai * 128 + m * 16) * 4);
#pragma unroll
        for (int ai = 0; ai < 2; ++ai)
#pragma unroll
            for (int m = 0; m < 4; ++m) { const int rl = rl0 + ai * 128 + m * 16; const float rs_ = r[ai][m];
#pragma unroll
                for (int bj = 0; bj < 2; ++bj) { const int col = col0 + bj * 128; const f32x4 v0 = acc[ai][bj][m][0] * rs_, v1 = acc[ai][bj][m][1] * rs_;
                    v4u w; w.x = cvtpk(v0[0], v0[1]); w.y = cvtpk(v0[2], v0[3]); w.z = cvtpk(v1[0], v1[1]); w.w = cvtpk(v1[2], v1[3]);
                    *(v4u*)(dst + (size_t)rl * DM + col) = w;
                    if (t > 0) { *(f32x4*)(fo + (size_t)rl * DM + col) = v0; *(f32x4*)(fo + (size_t)rl * DM + col + 4) = v1; } }
                asm volatile("" ::: "memory"); }
    }
};
struct EpiFfnUp {
    static constexpr bool PERM = true, PRE = true; static constexpr int NST = 32;
    bf16* H; float* UE; const float* rs; const float* cw; const float* cb;
    __device__ __forceinline__ void prefetch(LAS unsigned char* ep, const pg8::Unit& u, int wid, int lane) const {
        const int k = wid >> 1, half = wid & 1;
        const float* src = (k < 3 ? cw + (size_t)k * NUP : cb) + (half ? DFF : 0) + 128 * u.pn + lane;
        __builtin_amdgcn_global_load_lds((const unsigned*)src, (LAS unsigned*)(ep + (k * 256 + half * 128) * 4), 4, 0, 0);
        __builtin_amdgcn_global_load_lds((const unsigned*)(src + 64), (LAS unsigned*)(ep + (k * 256 + half * 128 + 64) * 4), 4, 0, 0);
        if (wid < 4) __builtin_amdgcn_global_load_lds((const unsigned*)(rs + u.pm * 256 + wid * 64 + lane), (LAS unsigned*)(ep + 4096 + wid * 256), 4, 0, 0);
    }
    __device__ __forceinline__ void operator()(AccT& acc, const pg8::Unit& u, int wr, int wc, int fr_in, int fq_in, LAS unsigned char* ep) const {
        int fr = fr_in, fq = fq_in; asm volatile("" : "+v"(fr), "+v"(fq));
        const bool samp = u.pm >= 128; const int colg0 = 128 * u.pn + 32 * wc;
        const LAS char* rsb = (const LAS char*)ep + 4096 + (wr * 64 + fr) * 4;
        float r[2][4];
#pragma unroll
        for (int ai = 0; ai < 2; ++ai)
#pragma unroll
            for (int m = 0; m < 4; ++m) r[ai][m] = *(const LAS float*)(rsb + (ai * 128 + m * 16) * 4);
        const LAS char* cwl = (const LAS char*)ep + (32 * wc + 8 * fq) * 4;
#pragma unroll
        for (int ai = 0; ai < 2; ++ai)
#pragma unroll
            for (int m = 0; m < 4; ++m)
#pragma unroll
                for (int bj = 0; bj < 2; ++bj) { acc[ai][bj][m][0] *= r[ai][m]; acc[ai][bj][m][1] *= r[ai][m]; }
        {
            const unsigned cl = (unsigned)(8 * fq) * 4u;
#pragma unroll
            for (int ai = 0; ai < 2; ++ai)
#pragma unroll
                for (int m = 0; m < 4; ++m) {
                    const bool first = (fr < 2) && (m == 0 || (samp && m == 2)), lastr = (fr >= 14) && (m == 3 || (samp && m == 1));
                    if (first || lastr) { const int slot = first ? fr : fr - 12;
                        const int cbi = samp ? 512 + (u.pm - 128) * 8 + ai * 4 + wr * 2 + (m >> 1) : u.pm * 4 + ai * 2 + wr;
                        GAS char* p = (GAS char*)uni_f(UE + (size_t)cbi * 4 * NUP + colg0) + (unsigned)slot * (NUP * 4u) + cl;
#pragma unroll
                        for (int bj = 0; bj < 2; ++bj) { *(GAS f32x4*)(p + bj * DFF * 4) = acc[ai][bj][m][0]; *(GAS f32x4*)(p + bj * DFF * 4 + 16) = acc[ai][bj][m][1]; } } } }
        GAS char* Hb = (GAS char*)uni_f(H + (size_t)(u.pm * 256 + wr * 64) * DFF + colg0);
        const unsigned hl = (unsigned)(fr * DFF + 8 * fq) * 2u;
#pragma unroll
        for (int n = 0; n < 2; ++n) {
            f32x4 w0[2], w1[2], w2[2], bb[2];
#pragma unroll
            for (int bj = 0; bj < 2; ++bj) { const int c = (bj * 128 + 4 * n) * 4; w0[bj] = *(const LAS f32x4*)(cwl + c); w1[bj] = *(const LAS f32x4*)(cwl + 1024 + c); w2[bj] = *(const LAS f32x4*)(cwl + 2048 + c); bb[bj] = *(const LAS f32x4*)(cwl + 3072 + c); }
#pragma unroll
            for (int ai = 0; ai < 2; ++ai)
#pragma unroll
                for (int m = 0; m < 4; ++m) { f32x4 cv[2];
#pragma unroll
                    for (int bj = 0; bj < 2; ++bj)
#pragma unroll
                        for (int i = 0; i < 4; ++i) { const float cur = acc[ai][bj][m][n][i]; const float pv = acc[ai][bj][m > 0 ? m - 1 : 0][n][i];
                            const float t1 = DPP_F(0.f, pv, 0x10F, true), p1 = DPP_F(t1, cur, 0x111, false);
                            const float t2 = DPP_F(0.f, pv, 0x10E, true), p2 = DPP_F(t2, cur, 0x112, false);
                            cv[bj][i] = bb[bj][i] + w0[bj][i] * p2 + w1[bj][i] * p1 + w2[bj][i] * cur; }
                    v2u w; { const float h0 = gelu_tanh(cv[0][0]) * cv[1][0], h1 = gelu_tanh(cv[0][1]) * cv[1][1], h2 = gelu_tanh(cv[0][2]) * cv[1][2], h3 = gelu_tanh(cv[0][3]) * cv[1][3];
                        w.x = cvtpk(h0, h1); w.y = cvtpk(h2, h3); }
                    *(GAS v2u*)(Hb + hl + (unsigned)((ai * 128 + m * 16) * DFF + 4 * n) * 2u) = w;
                    __builtin_amdgcn_sched_barrier(0); } }
    }
};

struct Ctx {
    LAS unsigned char* lds; unsigned char* ws; float* out; int vcu, G;
};
__device__ __forceinline__ void p0_prologue(const Ctx& F, const Args& a) {
    const int tid = opaque_tid(), lane = tid & 63, wave = __builtin_amdgcn_readfirstlane(tid >> 6);
    LAS float* scr = (LAS float*)(F.lds + RING_OFF + wave * 16640);
    const int gw = F.vcu * NWAVES + wave, NGW = F.G * NWAVES;
    constexpr int I_WIN = (DM / 64) * (4096 / 64), I_RGO = (DM / 64) * (DM / 64), I_QKV = (DM / 64) * (NQKV / 64), I_ATO = I_RGO, I_UP = (DM / 64) * (NUP / 64), I_DN = (DFF / 64) * (DM / 64), I_GW = 2 * 4;
    static_assert(8 * 16640 <= LDSCTL_OFF, "prologue scratch");
    static_assert(RING_BYTES + 2 * 5120 <= LDSCTL_OFF, "epilogue tables behind the GEMM ring");
    constexpr int NITEMS = I_WIN + I_RGO + I_QKV + I_ATO + 2 * I_UP + 2 * I_DN + 16 * I_GW;
    for (int it = gw; it < NITEMS; it += NGW) {
        int r = it;
        if (r < I_WIN) { p0_transpose_item(a.in[I_RGWIN], a.in[I_RGNORM], DM, 4096, (bf16*)(F.ws + WS_WIN), 0, scr, r, lane); continue; } r -= I_WIN;
        if (r < I_RGO) { p0_transpose_item(a.in[I_RGWOUT], nullptr, DM, DM, (bf16*)(F.ws + WS_RGO), 0, scr, r, lane); continue; } r -= I_RGO;
        if (r < I_QKV) { p0_transpose_item(a.in[I_ATWQKV], a.in[I_ATNORM], DM, NQKV, (bf16*)(F.ws + WS_QKV), 0, scr, r, lane); continue; } r -= I_QKV;
        if (r < I_ATO) { p0_transpose_item(a.in[I_ATWOUT], nullptr, DM, DM, (bf16*)(F.ws + WS_ATO), 0, scr, r, lane); continue; } r -= I_ATO;
        if (r < I_UP) { p0_transpose_item(a.in[I_FFNWUP], a.in[I_FFNNORM], DM, NUP, (bf16*)(F.ws + WS_UP0), 1, scr, r, lane); continue; } r -= I_UP;
        if (r < I_UP) { p0_transpose_item(a.in[I_FFNWUP] + (size_t)DM * NUP, a.in[I_FFNNORM] + DM, DM, NUP, (bf16*)(F.ws + WS_UP1), 1, scr, r, lane); continue; } r -= I_UP;
        if (r < I_DN) { p0_transpose_item(a.in[I_FFNWDN], nullptr, DFF, DM, (bf16*)(F.ws + WS_DN0), 0, scr, r, lane); continue; } r -= I_DN;
        if (r < I_DN) { p0_transpose_item(a.in[I_FFNWDN] + (size_t)DFF * DM, nullptr, DFF, DM, (bf16*)(F.ws + WS_DN1), 0, scr, r, lane); continue; } r -= I_DN;
        { const int n = r / I_GW, rr = r % I_GW;
          p0_transpose_item(a.in[I_RGGW] + (size_t)n * 128 * 256, nullptr, 128, 256, (bf16*)(F.ws + WS_GW) + (size_t)n * 256 * 128, 0, scr, rr, lane); }
    }
    bf16* XB = (bf16*)(F.ws + WS_XB); float* rs0 = (float*)(F.ws + WS_SS) + RS_OFF;
    f32x4 v[8];
#pragma unroll
    for (int j = 0; j < 8; ++j) v[j] = (f32x4){0.f, 0.f, 0.f, 0.f};
    int m = gw;
    if (m < MT) { const GAS f32x4* xv = (const GAS f32x4*)((m < MP) ? a.in[I_XP] + (size_t)m * DM : a.in[I_XS] + (size_t)(m - MP) * DM) + lane;
#pragma unroll
        for (int j = 0; j < 8; ++j) v[j] = xv[64 * j]; }
    while (m < MT) {
        const int mn = m + NGW; f32x4 vn[8];
#pragma unroll
        for (int j = 0; j < 8; ++j) vn[j] = (f32x4){0.f, 0.f, 0.f, 0.f};
        if (mn < MT) { const GAS f32x4* xn = (const GAS f32x4*)((mn < MP) ? a.in[I_XP] + (size_t)mn * DM : a.in[I_XS] + (size_t)(mn - MP) * DM) + lane;
#pragma unroll
            for (int j = 0; j < 8; ++j) vn[j] = xn[64 * j]; }
        asm volatile("" ::: "memory");
        float s = 0.f;
#pragma unroll
        for (int j = 0; j < 8; ++j) s += (v[j][0] * v[j][0] + v[j][1] * v[j][1]) + (v[j][2] * v[j][2] + v[j][3] * v[j][3]);
        s = wave_sum(s);
        GAS v2u* o8 = (GAS v2u*)(XB + (size_t)m * DM) + lane;
#pragma unroll
        for (int j = 0; j < 8; ++j) { v2u w; w.x = cvtpk(v[j][0], v[j][1]); w.y = cvtpk(v[j][2], v[j][3]); o8[64 * j] = w; }
        if (lane == 0) rs0[m] = __builtin_amdgcn_rsqf(s * (1.0f / DM) + EPS);
#pragma unroll
        for (int j = 0; j < 8; ++j) v[j] = vn[j];
        m = mn;
    }
}

constexpr int RG_REC = 0, RG_Y = 35840, RG_XCF = 53248, RG_XCB = 87040, RG_HY = 104448;
static_assert(RG_HY + 64 * 136 * 2 <= RING_BYTES, "rglru LDS map");
__device__ __forceinline__ void rglru_phase(const Ctx& F, const Args& a) {
    const int tid = opaque_tid(), lane = tid & 63, wid = __builtin_amdgcn_readfirstlane(tid >> 6), col = lane & 15, quad = lane >> 4;
    LAS float* recf = (LAS float*)(F.lds + RG_REC); LAS unsigned short* ytile = (LAS unsigned short*)(F.lds + RG_Y);
    LAS float* xcf = (LAS float*)(F.lds + RG_XCF); LAS unsigned short* xcb = (LAS unsigned short*)(F.lds + RG_XCB); LAS unsigned short* hyt = (LAS unsigned short*)(F.lds + RG_HY);
    const bf16* U = (const bf16*)(F.ws + WS_U); bf16* HY = (bf16*)(F.ws + WS_HY); const bf16* GWt = (const bf16*)(F.ws + WS_GW);
    for (int unit = blockIdx.x; unit < 512; unit += F.G) {
        const bool samp = unit >= 256; const int uu = samp ? unit - 256 : unit, b = uu >> 4, n = uu & 15;
        const int T = samp ? DECS : SEQ, row0 = samp ? MP + DECS * b : SEQ * b;
        bf16x8 Br[4], Bi[4];
        { const bf16* gw = GWt + (size_t)n * 256 * 128;
#pragma unroll
          for (int ks = 0; ks < 4; ++ks) { Br[ks] = *(const bf16x8*)(gw + (size_t)(16 * wid + col) * 128 + 32 * ks + 8 * quad); Bi[ks] = *(const bf16x8*)(gw + (size_t)(128 + 16 * wid + col) * 128 + 32 * ks + 8 * quad); } }
        const int ch = 128 * n + 16 * wid + col;
        const float gbr = a.in[I_RGGB][n * 256 + 16 * wid + col], gbi = a.in[I_RGGB][n * 256 + 128 + 16 * wid + col];
        const float sp8 = 8.f * log1pf(__expf(-a.in[I_RGLL][ch]));
        float hcar = samp ? a.in[I_SRGH][b * 2048 + ch] : 0.f;
        const int cc = tid & 127, rg4 = tid >> 7, cch = 128 * n + cc;
        const float cw0 = a.in[I_RGCW][cch], cw1 = a.in[I_RGCW][2048 + cch], cw2 = a.in[I_RGCW][4096 + cch], cw3 = a.in[I_RGCW][6144 + cch], cbias = a.in[I_RGCB][cch];
        float* o_rgc = F.out + (samp ? O_RGC_S : O_RGC_P); float* o_rgh = F.out + (samp ? O_RGH_S : O_RGH_P);
        const int r = tid >> 4, c8 = (tid & 15) * 8;
        const bf16* Urec = U + (size_t)row0 * 4096 + 2048 + 128 * n + c8; const bf16* Uy = U + (size_t)row0 * 4096 + 128 * n + c8;
        v4u rraw[3], yraw[2];
#define RG_LOAD(t0_) do { _Pragma("unroll") for (int p = 0; p < 3; ++p) { const int rr = 32 * p + r, t = (t0_) - 3 + rr; rraw[p] = (v4u){0u, 0u, 0u, 0u}; if (rr < 67 && t >= 0 && t < T) rraw[p] = *(const v4u*)(Urec + (size_t)t * 4096); } \
        _Pragma("unroll") for (int p = 0; p < 2; ++p) { const int t = (t0_) + 32 * p + r; yraw[p] = (v4u){0u, 0u, 0u, 0u}; if (t < T) yraw[p] = *(const v4u*)(Uy + (size_t)t * 4096); } } while (0)
        RG_LOAD(0);
        for (int t0 = 0; t0 < T; t0 += 64) {
#pragma unroll
            for (int p = 0; p < 3; ++p) { const int rr = 32 * p + r; if (rr < 67) { const int t = t0 - 3 + rr; const v4u w = rraw[p];
                    f32x4 lo = (f32x4){__builtin_bit_cast(float, w.x << 16), __builtin_bit_cast(float, w.x & 0xffff0000u), __builtin_bit_cast(float, w.y << 16), __builtin_bit_cast(float, w.y & 0xffff0000u)};
                    f32x4 hi = (f32x4){__builtin_bit_cast(float, w.z << 16), __builtin_bit_cast(float, w.z & 0xffff0000u), __builtin_bit_cast(float, w.w << 16), __builtin_bit_cast(float, w.w & 0xffff0000u)};
                    if (t < 0 && samp) { const float* sp = a.in[I_SRGC] + (size_t)(b * 3 + 3 + t) * 2048 + 128 * n + c8; lo = *(const f32x4*)sp; hi = *(const f32x4*)(sp + 4); }
                    *(LAS f32x4*)(recf + rr * 132 + c8) = lo; *(LAS f32x4*)(recf + rr * 132 + c8 + 4) = hi; } }
#pragma unroll
            for (int p = 0; p < 2; ++p) *(LAS v4u*)(ytile + (32 * p + r) * 136 + c8) = yraw[p];
            LDS_WAIT(); __syncthreads();
            if (t0 + 64 < T) RG_LOAD(t0 + 64);
            { float x[19];
#pragma unroll
              for (int k = 0; k < 19; ++k) x[k] = recf[(16 * rg4 + k) * 132 + cc];
#pragma unroll
              for (int i = 0; i < 16; ++i) { const float xc = cbias + cw0 * x[i] + cw1 * x[i + 1] + cw2 * x[i + 2] + cw3 * x[i + 3];
                    xcf[(16 * rg4 + i) * 132 + cc] = xc; xcb[(16 * rg4 + i) * 136 + cc] = (unsigned short)(cvtpk(xc, 0.f) & 0xffffu); }
              if (t0 + 64 >= T && tid < 384) { const int k = tid >> 7; o_rgc[(size_t)(b * 3 + k) * 2048 + cch] = recf[(T - t0 + k) * 132 + cc]; } }
            LDS_WAIT(); __syncthreads();
#pragma unroll
            for (int rb = 0; rb < 4; ++rb) {
                if (t0 + 16 * rb < T) {
                    f32x4 accR = {0.f, 0.f, 0.f, 0.f}, accI = accR;
#pragma unroll
                    for (int ks = 0; ks < 4; ++ks) { const bf16x8 af = *(const LAS bf16x8*)(xcb + (16 * rb + col) * 136 + 32 * ks + 8 * quad);
                        accR = __builtin_amdgcn_mfma_f32_16x16x32_bf16(af, Br[ks], accR, 0, 0, 0); accI = __builtin_amdgcn_mfma_f32_16x16x32_bf16(af, Bi[ks], accI, 0, 0, 0); }
                    float av[4], bv[4]; float As = 1.f, Bs = 0.f;
#pragma unroll
                    for (int j = 0; j < 4; ++j) { const int t = 16 * rb + 4 * quad + j; const float xc = xcf[t * 132 + 16 * wid + col];
                        const float rg = sigmoidf_(accR[j] + gbr), ig = sigmoidf_(accI[j] + gbi), la = -sp8 * rg, aa = __builtin_amdgcn_exp2f(la * 1.4426950409f), x2 = 2.f * la;
                        const float om = (x2 > -0.02f) ? -x2 * (1.f + x2 * (0.5f + x2 * (0.16666667f + x2 * 0.041666668f))) : 1.f - aa * aa;
                        av[j] = aa; bv[j] = __builtin_sqrtf(om) * ig * xc; Bs = aa * Bs + bv[j]; As = aa * As; }
                    const float A0 = __shfl(As, col), B0 = __shfl(Bs, col), A1 = __shfl(As, col + 16), B1 = __shfl(Bs, col + 16), A2 = __shfl(As, col + 32), B2 = __shfl(Bs, col + 32), A3 = __shfl(As, col + 48), B3 = __shfl(Bs, col + 48);
                    const float h1 = A0 * hcar + B0, h2 = A1 * h1 + B1, h3 = A2 * h2 + B2, h4 = A3 * h3 + B3;
                    float hs = quad == 0 ? hcar : (quad == 1 ? h1 : (quad == 2 ? h2 : h3)); hcar = h4;
#pragma unroll
                    for (int j = 0; j < 4; ++j) { const int t = 16 * rb + 4 * quad + j; hs = av[j] * hs + bv[j];
                        const float y = bf2f(ytile[t * 136 + 16 * wid + col]);
                        hyt[t * 136 + 16 * wid + col] = (unsigned short)(cvtpk(hs * y, 0.f) & 0xffffu); }
                    if (t0 + 16 * (rb + 1) == T && quad == 0) o_rgh[(size_t)b * 2048 + ch] = hcar;
                }
            }
            LDS_WAIT(); __syncthreads();
#pragma unroll
            for (int p = 0; p < 2; ++p) { const int rr = 32 * p + r; if (t0 + rr < T) *(v4u*)(HY + (size_t)(row0 + t0 + rr) * DM + 128 * n + c8) = *(const LAS v4u*)(hyt + rr * 136 + c8); }
        }
        LDS_WAIT(); __syncthreads();
#undef RG_LOAD
    }
}

__device__ __forceinline__ void ffn_fixup(const Ctx& F, const Args& a, int layer) {
    const float* UE = (const float*)(F.ws + WS_UE); bf16* H = (bf16*)(F.ws + WS_H);
    const float* cw = a.in[I_FFNCW] + (size_t)layer * 3 * NUP; const float* cb = a.in[I_FFNCB] + (size_t)layer * NUP;
    const int tid = opaque_tid();
    const long gt = (long)F.vcu * 512 + tid, NT_ = (long)F.G * 512;
    constexpr int FG = DFF / 4;
    for (long it = gt; it < (long)NCB * FG; it += NT_) {
        const int cbi = (int)(it / FG), j = (int)(it % FG) * 4;
        const bool samp = cbi >= 512; const int rowA = samp ? MP + (cbi - 512) * 32 : cbi * 64;
        f32x4 u0[2], u1[2], hm2[2], hm1[2];
#pragma unroll
        for (int bj = 0; bj < 2; ++bj) { const int c = j + bj * DFF;
            u0[bj] = *(const f32x4*)(UE + ((size_t)cbi * 4 + 0) * NUP + c); u1[bj] = *(const f32x4*)(UE + ((size_t)cbi * 4 + 1) * NUP + c);
            if (samp) { const float* st = a.in[I_SFFN] + ((size_t)(layer * 16 + (cbi - 512)) * 2) * NUP + c; hm2[bj] = *(const f32x4*)st; hm1[bj] = *(const f32x4*)(st + NUP); }
            else if ((cbi & 31) == 0) { hm2[bj] = (f32x4){0.f, 0.f, 0.f, 0.f}; hm1[bj] = hm2[bj]; }
            else { hm2[bj] = *(const f32x4*)(UE + ((size_t)(cbi - 1) * 4 + 2) * NUP + c); hm1[bj] = *(const f32x4*)(UE + ((size_t)(cbi - 1) * 4 + 3) * NUP + c); } }
        f32x4 c0[2], c1[2];
#pragma unroll
        for (int bj = 0; bj < 2; ++bj) { const int c = j + bj * DFF; const f32x4 w0 = *(const f32x4*)(cw + c), w1 = *(const f32x4*)(cw + NUP + c), w2 = *(const f32x4*)(cw + 2 * NUP + c), bb = *(const f32x4*)(cb + c);
            c0[bj] = bb + w0 * hm2[bj] + w1 * hm1[bj] + w2 * u0[bj]; c1[bj] = bb + w0 * hm1[bj] + w1 * u0[bj] + w2 * u1[bj]; }
        v2u o0, o1; float h0[4], h1[4];
#pragma unroll
        for (int i = 0; i < 4; ++i) { h0[i] = gelu_tanh(c0[0][i]) * c0[1][i]; h1[i] = gelu_tanh(c1[0][i]) * c1[1][i]; }
        o0.x = cvtpk(h0[0], h0[1]); o0.y = cvtpk(h0[2], h0[3]); o1.x = cvtpk(h1[0], h1[1]); o1.y = cvtpk(h1[2], h1[3]);
        *(v2u*)(H + (size_t)rowA * DFF + j) = o0; *(v2u*)(H + (size_t)(rowA + 1) * DFF + j) = o1;
    }
    constexpr int NV = NUP / 4;
    for (long it = gt; it < (long)32 * 2 * NV; it += NT_) {
        const int sq = (int)(it / (2 * NV)), r = (int)((it / NV) & 1), c = (int)(it % NV) * 4;
        const bool samp = sq >= 16; const int cbi = samp ? 512 + (sq - 16) : 32 * sq + 31;
        float* o = F.out + (samp ? O_FFN_S : O_FFN_P) + ((size_t)(layer * 16 + (samp ? sq - 16 : sq)) * 2 + r) * NUP + c;
        *(f32x4*)o = *(const f32x4*)(UE + ((size_t)cbi * 4 + 2 + r) * NUP + c);
    }
}

__device__ __forceinline__ void resid_finish(const Ctx& F, const float* baseS, int f, float* ssout) {
    const int tid = opaque_tid(), lane = tid & 63, wave = __builtin_amdgcn_readfirstlane(tid >> 6);
    const int gw = F.vcu * NWAVES + wave, NGW = F.G * NWAVES;
    const float* slab = (const float*)(F.ws + WS_SLAB); bf16* XB = (bf16*)(F.ws + WS_XB);
    for (int r = gw; r < MS; r += NGW) {
        f32x4 v[8];
#pragma unroll
        for (int j = 0; j < 8; ++j) v[j] = *((const GAS f32x4*)(baseS + (size_t)r * DM) + lane + 64 * j);
        for (int ks = 0; ks < f; ++ks) { const GAS f32x4* sp = (const GAS f32x4*)(slab + ((size_t)ks * MS + r) * DM) + lane;
#pragma unroll
            for (int j = 0; j < 8; ++j) v[j] += sp[64 * j]; }
        float q = 0.f;
        GAS f32x4* xo = (GAS f32x4*)(F.out + (size_t)(MP + r) * DM) + lane; GAS v2u* bo = (GAS v2u*)(XB + (size_t)(MP + r) * DM) + lane;
#pragma unroll
        for (int j = 0; j < 8; ++j) { xo[64 * j] = v[j]; v2u w; w.x = cvtpk(v[j][0], v[j][1]); w.y = cvtpk(v[j][2], v[j][3]); bo[64 * j] = w;
            q += (v[j][0] * v[j][0] + v[j][1] * v[j][1]) + (v[j][2] * v[j][2] + v[j][3] * v[j][3]); }
        q = wave_sum(q);
        if (lane == 0) ssout[RS_OFF + MP + r] = __builtin_amdgcn_rsqf(q * (1.0f / DM) + EPS);
    }
    for (long row = (long)(F.G - 1 - F.vcu) * 512 + tid; row < MP; row += (long)F.G * 512) {
        const GAS f32x4* p = (const GAS f32x4*)(ssout + (size_t)row * 32); f32x4 a[8];
#pragma unroll
        for (int j = 0; j < 8; ++j) a[j] = p[j];
        float sq = 0.f;
#pragma unroll
        for (int j = 0; j < 8; ++j) sq += (a[j][0] + a[j][1]) + (a[j][2] + a[j][3]);
        ssout[RS_OFF + row] = __builtin_amdgcn_rsqf(sq * (1.0f / DM) + EPS);
    }
}

__device__ __forceinline__ void final_norm(const Ctx& F, const Args& a, const float* ss) {
    const int tid = opaque_tid(), lane = tid & 63, wave = __builtin_amdgcn_readfirstlane(tid >> 6);
    const int gw = F.vcu * NWAVES + wave, NGW = F.G * NWAVES;
    const GAS f32x4* gv = (const GAS f32x4*)a.in[I_FINNORM] + lane;
    f32x4 g[8], v[8]; float rs = 0.f;
#pragma unroll
    for (int j = 0; j < 8; ++j) { g[j] = gv[64 * j]; v[j] = (f32x4){0.f, 0.f, 0.f, 0.f}; }
    int m = gw;
    if (m < MT) { rs = ss[RS_OFF + m]; const GAS f32x4* xv = (const GAS f32x4*)(F.out + (size_t)m * DM) + lane;
#pragma unroll
        for (int j = 0; j < 8; ++j) v[j] = xv[64 * j]; }
    while (m < MT) {
        const int mn = m + NGW; f32x4 vn[8]; float rsn = 0.f;
#pragma unroll
        for (int j = 0; j < 8; ++j) vn[j] = (f32x4){0.f, 0.f, 0.f, 0.f};
        if (mn < MT) { rsn = ss[RS_OFF + mn]; const GAS f32x4* xn = (const GAS f32x4*)(F.out + (size_t)mn * DM) + lane;
#pragma unroll
            for (int j = 0; j < 8; ++j) vn[j] = xn[64 * j]; }
        asm volatile("" ::: "memory");
        GAS f32x4* xo = (GAS f32x4*)(F.out + (size_t)m * DM) + lane;
#pragma unroll
        for (int j = 0; j < 8; ++j) xo[64 * j] = v[j] * rs * g[j];
#pragma unroll
        for (int j = 0; j < 8; ++j) v[j] = vn[j];
        rs = rsn; m = mn;
    }
}

namespace att {
constexpr int QBLK = 32, KVBLK = 64, QB = 256, PITCH = DM;
constexpr int SHM_V = 16384, SHM_K = 16384, A_V = 0, A_K = 32768, A_WS = 65536;
constexpr float SCALE = 0.08838834764831845f, THR = 8.f, C2 = 1.4426950408889634f * SCALE;
#define KSWZ(row, colB) ((row) * 256 + ((colB) ^ (((row) & 7) << 4)))
#define SBAR() __builtin_amdgcn_sched_barrier(0)
__device__ __forceinline__ int v_st(int k, int c) { const int kk = (k & ~0xC) | ((k & 4) << 1) | ((k & 8) >> 1); return ((kk >> 3) * 4 + (c >> 5)) * 512 + ((kk & 7) * 32 + (c & 31)) * 2; }
__device__ __forceinline__ int v_rd_base(int lane) { return ((lane & 3) << 3) | (((lane >> 2) & 3) << 6) | (((lane >> 4) & 1) << 5) | (((lane >> 5) & 1) << 8); }
constexpr int v_rd_off(int d0, int ks, int half) { return d0 * 512 + ks * 4096 + half * 2048; }
__device__ __forceinline__ int crow(int r, int hi) { return (r & 3) + 8 * (r >> 2) + 4 * hi; }
__device__ __forceinline__ void partialSM(f32x16& p0, f32x16& p1, float& m_reg, float& mn, float& alpha) {
    float pmax = p0[0];
#pragma unroll
    for (int r = 1; r < 16; ++r) pmax = fmaxf(pmax, p0[r]);
#pragma unroll
    for (int r = 0; r < 16; ++r) pmax = fmaxf(pmax, p1[r]);
    { auto rr = __builtin_amdgcn_permlane32_swap(__float_as_uint(pmax), __float_as_uint(pmax), false, false);
      pmax = fmaxf(__uint_as_float(rr[0]), __uint_as_float(rr[1])); }
    if (__builtin_expect(__all((pmax - m_reg) * SCALE <= THR), 1)) { mn = m_reg; alpha = 1.f; }
    else { mn = fmaxf(m_reg, pmax); alpha = __builtin_amdgcn_exp2f((m_reg - mn) * C2); m_reg = mn; }
    const float mnL = -mn * C2;
#pragma unroll
    for (int r = 0; r < 16; ++r) p0[r] = fmaf(p0[r], C2, mnL);
#pragma unroll
    for (int r = 0; r < 16; ++r) p1[r] = fmaf(p1[r], C2, mnL);
#pragma unroll
    for (int r = 0; r < 16; ++r) p0[r] = __builtin_amdgcn_exp2f(p0[r]);
}
__device__ __forceinline__ void finishSM(f32x16& p0, f32x16& p1, float alpha, float& l_reg, bf16x8& pa0, bf16x8& pa1, bf16x8& pa2, bf16x8& pa3) {
#pragma unroll
    for (int r = 0; r < 16; ++r) p1[r] = __builtin_amdgcn_exp2f(p1[r]);
    float ps = 0;
#pragma unroll
    for (int r = 0; r < 16; ++r) ps += p0[r];
#pragma unroll
    for (int r = 0; r < 16; ++r) ps += p1[r];
    { auto rr = __builtin_amdgcn_permlane32_swap(__float_as_uint(ps), __float_as_uint(ps), false, false);
      ps = __uint_as_float(rr[0]) + __uint_as_float(rr[1]); }
    l_reg = l_reg * alpha + ps;
#define PK4(P, B_, OUT) do { unsigned a0 = cvtpk(P[B_+0], P[B_+1]), a1 = cvtpk(P[B_+2], P[B_+3]);                          \
        unsigned b0 = cvtpk(P[B_+4], P[B_+5]), b1 = cvtpk(P[B_+6], P[B_+7]);                                             \
        auto r0 = __builtin_amdgcn_permlane32_swap(a0, b0, false, false); auto r1 = __builtin_amdgcn_permlane32_swap(a1, b1, false, false); \
        v4u w = {r0[0], r1[0], r0[1], r1[1]}; OUT = __builtin_bit_cast(bf16x8, w); } while (0)
    PK4(p0, 0, pa0); PK4(p0, 8, pa1); PK4(p1, 0, pa2); PK4(p1, 8, pa3);
#undef PK4
}
template <int KB>
__device__ __forceinline__ void qkt(f32x16& p0, f32x16& p1, const LAS unsigned char* K_lds, int r32, int hi, const bf16x8* qr, bool act) {
    if (!act) { const float NEG = -__builtin_inff();
#pragma unroll
        for (int r = 0; r < 16; ++r) { p0[r] = NEG; p1[r] = NEG; } return; }
    p0 = f32x16{}; p1 = f32x16{};
    const LAS unsigned char* kb[4];
#pragma unroll
    for (int dd = 0; dd < 4; ++dd) kb[dd] = K_lds + KB * SHM_K + KSWZ(r32, (dd * 16 + hi * 8) * 2);
#pragma unroll
    for (int d0 = 0; d0 < 8; ++d0) { const LAS unsigned char* a = kb[d0 & 3] + (d0 >> 2) * 128;
        bf16x8 b0 = *reinterpret_cast<const LAS bf16x8*>(a);
        bf16x8 b1 = *reinterpret_cast<const LAS bf16x8*>(a + 32 * 256);
        p0 = __builtin_amdgcn_mfma_f32_32x32x16_bf16(b0, qr[d0], p0, 0, 0, 0);
        p1 = __builtin_amdgcn_mfma_f32_32x32x16_bf16(b1, qr[d0], p1, 0, 0, 0); }
}
template <int VB>
__device__ __forceinline__ void pv_tile(f32x16* o, int vb0, bf16x8 pa0, bf16x8 pa1, bf16x8 pa2, bf16x8 pa3, bool act) {
    if (!act) return;
#define TRRD(dst, off) asm volatile("ds_read_b64_tr_b16 %0, %1 offset:%2" : "=&v"(dst) : "v"(vb0), "i"(off) : "memory")
#define PV_D0(d0) do { s16x4 l0, l1, l2, l3, h0, h1, h2, h3; constexpr int b_ = VB * SHM_V + v_rd_off(d0, 0, 0); \
        TRRD(l0, b_); TRRD(h0, b_ + 2048); TRRD(l1, b_ + 4096); TRRD(h1, b_ + 6144); TRRD(l2, b_ + 8192); TRRD(h2, b_ + 10240); TRRD(l3, b_ + 12288); TRRD(h3, b_ + 14336); \
        asm volatile("s_waitcnt lgkmcnt(0)" ::: "memory"); SBAR();   \
        o[d0] = __builtin_amdgcn_mfma_f32_32x32x16_bf16(pa0, (bf16x8){l0[0], l0[1], l0[2], l0[3], h0[0], h0[1], h0[2], h0[3]}, o[d0], 0, 0, 0);   \
        o[d0] = __builtin_amdgcn_mfma_f32_32x32x16_bf16(pa1, (bf16x8){l1[0], l1[1], l1[2], l1[3], h1[0], h1[1], h1[2], h1[3]}, o[d0], 0, 0, 0);   \
        o[d0] = __builtin_amdgcn_mfma_f32_32x32x16_bf16(pa2, (bf16x8){l2[0], l2[1], l2[2], l2[3], h2[0], h2[1], h2[2], h2[3]}, o[d0], 0, 0, 0);   \
        o[d0] = __builtin_amdgcn_mfma_f32_32x32x16_bf16(pa3, (bf16x8){l3[0], l3[1], l3[2], l3[3], h3[0], h3[1], h3[2], h3[3]}, o[d0], 0, 0, 0); } while (0)
    PV_D0(0); PV_D0(1); PV_D0(2); PV_D0(3);
#undef PV_D0
#undef TRRD
}
struct BlockRef { const bf16* Q; const bf16* K; const bf16* V; int P0, mode, orow, h; };
struct Seam { bf16x8 qr[8]; bf16x8 st_v0, st_v1, st_k0, st_k1; };
__device__ __forceinline__ GAS char* uni(const void* p) { const unsigned long long b = (unsigned long long)p; const unsigned lo = __builtin_amdgcn_readfirstlane((unsigned)b), hi = __builtin_amdgcn_readfirstlane((unsigned)(b >> 32)); return (GAS char*)(((unsigned long long)hi << 32) | lo); }
#define ROW(p, k0, rr) (uni((const char*)(p) + (size_t)((k0) + (rr)) * (PITCH * 2)) + loff)
#define VMW() asm volatile("s_waitcnt vmcnt(0)" ::: "memory")
#define VMWN(n) asm volatile("s_waitcnt vmcnt(%0)" :: "i"(n) : "memory")
#define LD8(p) (*(const GAS bf16x8*)(p))
#define SLOAD_H(Kp, Vp, k0) do { S.st_v0 = LD8(ROW(Vp, k0, 0)); S.st_v1 = LD8(ROW(Vp, k0, 32)); S.st_k0 = LD8(ROW(Kp, k0, 0)); S.st_k1 = LD8(ROW(Kp, k0, 32)); } while (0)
#define SWRITE_HK(bf) do { *(LAS bf16x8*)(K_lds + (bf) * SHM_K + kws) = S.st_k0; *(LAS bf16x8*)(K_lds + (bf) * SHM_K + kws + 32 * 256) = S.st_k1; } while (0)
#define SWRITE_HV(bf) do { *(LAS bf16x8*)(V_lds + (bf) * SHM_V + vst0) = S.st_v0; *(LAS bf16x8*)(V_lds + (bf) * SHM_V + vst1) = S.st_v1; } while (0)
#define SWRITE_H(bf) do { SWRITE_HV(bf); SWRITE_HK(bf); } while (0)
__device__ __forceinline__ void prime(const BlockRef& cur, LAS unsigned char* lds, Seam& S) {
    const int tid = opaque_tid(), wid = __builtin_amdgcn_readfirstlane(tid >> 6), lane = tid & 63, r32 = lane & 31, hi = lane >> 5;
    const int sr = tid >> 4, sc = (tid & 15) * 8, kws = KSWZ(sr, sc * 2); LAS unsigned char* K_lds = lds + A_K;
    const unsigned loff = (unsigned)(sr * PITCH + sc) * 2u, qoff = (unsigned)(r32 * PITCH + hi * 8) * 2u;
#pragma unroll
    for (int d0 = 0; d0 < 8; ++d0) S.qr[d0] = LD8(uni(cur.Q + (size_t)(wid * QBLK) * PITCH) + qoff + d0 * 32);
    SLOAD_H(cur.K, cur.V, 0); VMW(); SWRITE_HK(0);
    __syncthreads();
}
__device__ __forceinline__ void block(const BlockRef& cur, const BlockRef& nxt, LAS unsigned char* lds, Seam& S, float lam, const float* subln, float* stash, bf16* OB) {
    const int tid = opaque_tid(), wid = __builtin_amdgcn_readfirstlane(tid >> 6), lane = tid & 63, r32 = lane & 31, hi = lane >> 5;
    const int NT = cur.P0 / KVBLK + 4;
    const int qe = (cur.P0 + wid * QBLK) | 63;
    LAS unsigned char* V_lds = lds + A_V; LAS unsigned char* K_lds = lds + A_K;
    LAS float* ws = (LAS float*)(lds + A_WS) + wid * 64; LAS float* li_l = ws; LAS float* al_l = ws + 32;
    float m_reg = -1e30f, l_reg = 0; f32x16 o[4] = {};
    const int sr = tid >> 4, sc = (tid & 15) * 8, vst0 = v_st(sr, sc), vst1 = v_st(32 + sr, sc), kws = KSWZ(sr, sc * 2);
    const unsigned loff = (unsigned)(sr * PITCH + sc) * 2u, qoff = (unsigned)(r32 * PITCH + hi * 8) * 2u;
    const int vb0 = (int)(unsigned)(uintptr_t)V_lds + v_rd_base(lane);
    const bf16* Kh = cur.K; const bf16* Vh = cur.V;
#define RESC(a) do { if (__any((a) < 1.f)) { if (hi == 0) al_l[r32] = (a); asm volatile("s_waitcnt lgkmcnt(0)" ::: "memory");              \
                     for (int d_ = 0; d_ < 4; ++d_) for (int r = 0; r < 16; ++r) o[d_][r] *= al_l[crow(r, hi)]; } } while (0)
#define KBASE(t) ((t) * KVBLK)
#define ACT(t) (KBASE(t) <= qe)
#define SEAM_K0() do { VMWN(8); SWRITE_HK(0); SBAR(); } while (0)
    f32x16 pA0, pA1, pB0, pB1; float mnA, mnB, alA, alB; bf16x8 pa0, pa1, pa2, pa3;
    SWRITE_HV(0); SBAR();
    if (NT > 1) SLOAD_H(Kh, Vh, KBASE(1));
    SBAR(); qkt<0>(pA0, pA1, K_lds, r32, hi, S.qr, ACT(0));
    partialSM(pA0, pA1, m_reg, mnA, alA);
    if (NT > 1) { VMW(); SWRITE_H(1); }
    __syncthreads();
#define HALF_STEP(PX0, PX1, mnX, alX, PY0, PY1, alY, t, KB, VB, SB) do {                                                      \
        SBAR(); qkt<KB>(PX0, PX1, K_lds, r32, hi, S.qr, ACT(t));                                             \
        finishSM(PY0, PY1, alY, l_reg, pa0, pa1, pa2, pa3); SBAR();                                                           \
        if ((t) + 1 < NT) { SLOAD_H(Kh, Vh, KBASE((t) + 1)); SBAR(); }                                               \
        pv_tile<VB>(o, vb0, pa0, pa1, pa2, pa3, ACT((t) - 1)); partialSM(PX0, PX1, m_reg, mnX, alX);                                        \
        __syncthreads();                                                                                                      \
        if ((t) + 1 < NT) { VMW(); SWRITE_H(SB); }                                                                          \
        RESC(alX); __syncthreads(); } while (0)
    for (int t = 1; t + 1 < NT; t += 2) {
        HALF_STEP(pB0, pB1, mnB, alB, pA0, pA1, alA, t, 1, 0, 0);
        HALF_STEP(pA0, pA1, mnA, alA, pB0, pB1, alB, t + 1, 0, 1, 1);
    }
    SBAR(); qkt<1>(pB0, pB1, K_lds, r32, hi, S.qr, ACT(NT - 1)); SBAR();
    SLOAD_H(nxt.K, nxt.V, 0); SBAR();
#pragma unroll
    for (int d0 = 0; d0 < 8; ++d0) S.qr[d0] = LD8(uni(nxt.Q + (size_t)(wid * QBLK) * PITCH) + qoff + d0 * 32);
    SBAR();
    finishSM(pA0, pA1, alA, l_reg, pa0, pa1, pa2, pa3); SBAR();
    pv_tile<0>(o, vb0, pa0, pa1, pa2, pa3, ACT(NT - 2));
    partialSM(pB0, pB1, m_reg, mnB, alB); __syncthreads(); RESC(alB);
    finishSM(pB0, pB1, alB, l_reg, pa0, pa1, pa2, pa3); SBAR(); pv_tile<1>(o, vb0, pa0, pa1, pa2, pa3, ACT(NT - 1));
    SBAR(); SEAM_K0();
    if (hi == 0) li_l[r32] = l_reg; asm volatile("s_waitcnt lgkmcnt(0)" ::: "memory");
    float rli[16];
#pragma unroll
    for (int r = 0; r < 16; ++r) rli[r] = __builtin_amdgcn_rcpf(li_l[crow(r, hi)]);
    GAS char* stb = uni(stash + ((size_t)(blockIdx.x * NWAVES + wid) * ST_PER_LANE) * 64);
    const unsigned sl = (unsigned)lane * 4u;
#define ST_AT(idx) (*(GAS float*)(stb + (size_t)(idx) * 256 + sl))
#define MFENCE() asm volatile("" ::: "memory")
    const int mode = cur.mode;
    if ((mode & 1) == 0) {
#pragma unroll
        for (int d0 = 0; d0 < 4; ++d0) {
#pragma unroll
            for (int r = 0; r < 16; ++r) ST_AT(d0 * 16 + r) = o[d0][r] * rli[r];
            MFENCE(); }
    } else if (mode == 1) {
        float ssp[16];
#pragma unroll
        for (int r = 0; r < 16; ++r) ssp[r] = 0.f;
#pragma unroll
        for (int d0 = 0; d0 < 4; ++d0) { float t2[16];
#pragma unroll
            for (int r = 0; r < 16; ++r) t2[r] = ST_AT(d0 * 16 + r);
#pragma unroll
            for (int r = 0; r < 16; ++r) { const float x = o[d0][r] * rli[r] - lam * t2[r]; ST_AT(64 + d0 * 16 + r) = x; ssp[r] += x * x; }
            MFENCE(); }
#pragma unroll
        for (int r = 0; r < 16; ++r) ST_AT(128 + r) = ssp[r];
    } else {
        float ssp[16];
#pragma unroll
        for (int r = 0; r < 16; ++r) ssp[r] = ST_AT(128 + r);
#pragma unroll
        for (int d0 = 0; d0 < 4; ++d0) { float t2[16];
#pragma unroll
            for (int r = 0; r < 16; ++r) t2[r] = ST_AT(d0 * 16 + r);
#pragma unroll
            for (int r = 0; r < 16; ++r) { const float x = o[d0][r] * rli[r] - lam * t2[r]; o[d0][r] = x; ssp[r] += x * x; }
            MFENCE(); }
#pragma unroll
        for (int r = 0; r < 16; ++r) { float q = ssp[r]; q += __shfl_xor(q, 1); q += __shfl_xor(q, 2); q += __shfl_xor(q, 4); q += __shfl_xor(q, 8); q += __shfl_xor(q, 16);
            ssp[r] = __builtin_amdgcn_rsqf(q * (1.0f / 256.0f) + EPS) * (1.0f - LAMBDA_INIT); }
        GAS char* Owb = uni(OB + (size_t)(cur.orow + wid * QBLK) * DM + cur.h * 256);
        const unsigned ol = (unsigned)(4 * hi * DM + r32) * 2u;
#pragma unroll
        for (int d0 = 0; d0 < 4; ++d0) { const float g1 = subln[128 + d0 * 32 + r32], g0 = subln[d0 * 32 + r32];
#pragma unroll
            for (int r = 0; r < 16; ++r) { const unsigned ro = ol + (unsigned)(((r & 3) + 8 * (r >> 2)) * DM + d0 * 32) * 2u;
                const float v1 = o[d0][r] * ssp[r] * g1, v0 = ST_AT(64 + d0 * 16 + r) * ssp[r] * g0;
                const float v1n = __shfl_xor(v1, 1), v0n = __shfl_xor(v0, 1);
                if ((r32 & 1) == 0) { *(GAS unsigned*)(Owb + ro + 256) = cvtpk(v1, v1n); *(GAS unsigned*)(Owb + ro) = cvtpk(v0, v0n); }
                if ((r & 3) == 3) MFENCE(); } }
    }
#undef ST_AT
#undef MFENCE
    __syncthreads();
#undef RESC
#undef KBASE
#undef ACT
#undef SEAM_K0
#undef HALF_STEP
}
#undef SLOAD_H
#undef SWRITE_HK
#undef SWRITE_HV
#undef SWRITE_H

__device__ __forceinline__ BlockRef decode(int k, int c, int G, const bf16* Qb, const bf16* Kb, const bf16* Vb) {
    const int L = c + (k >> 3) * G, sub = k & 7, pass = sub >> 2, run = sub & 3, bh = L >> 2, x = L & 3, qb = pass ? 7 - x : x, b = bh >> 3, h = bh & 7;
    const int mapj = (run & 1) ? 0 : 1, vh = run >> 1, hv = 2 * h + mapj;
    BlockRef r; r.Q = Qb + (size_t)(b * SEQ + qb * QB) * DM + hv * 128; r.K = Kb + (size_t)(b * SEQ) * DM + hv * 128; r.V = Vb + (size_t)(b * SEQ) * DM + h * 256 + vh * 128;
    r.P0 = qb * QB; r.mode = run; r.orow = b * SEQ + qb * QB; r.h = h; return r;
}

constexpr int B2_V = 0, B2_K = 32768, B2_Q = 69632;
static_assert(B2_Q + 8 * 32 * 136 * 2 <= LDSCTL_OFF && A_WS + 2048 <= B2_Q, "block2 LDS map");
__device__ __forceinline__ void block2(const BlockRef& cur, LAS unsigned char* lds, float lam, const float* subln, float* stash, bf16* OB) {
    const int tid = opaque_tid(), wid = __builtin_amdgcn_readfirstlane(tid >> 6), lane = tid & 63, r32 = lane & 31, hi = lane >> 5;
    const int NT = cur.P0 / 32 + 8;
    const int qe = (cur.P0 + wid * QBLK) | 63;
    LAS unsigned char* V_lds = lds + B2_V; LAS unsigned char* K_lds = lds + B2_K;
    LAS float* ws = (LAS float*)(lds + A_WS) + wid * 64; LAS float* li_l = ws; LAS float* al_l = ws + 32;
    const int sr = tid >> 4, sc = (tid & 15) * 8, vst = v_st(sr, sc), kws = KSWZ(sr, sc * 2);
    const unsigned loff = (unsigned)(sr * PITCH + sc) * 2u;
    const int vb0 = (int)(unsigned)(uintptr_t)V_lds + v_rd_base(lane);
    int kb[4];
#pragma unroll
    for (int dd = 0; dd < 4; ++dd) kb[dd] = KSWZ(r32, (dd * 16 + hi * 8) * 2);
    LAS unsigned short* QL = (LAS unsigned short*)(lds + B2_Q) + wid * (32 * 136);
    { const GAS char* qg = uni(cur.Q + (size_t)(wid * QBLK) * PITCH);
#pragma unroll
      for (int p = 0; p < 8; ++p) { const int id = lane + 64 * p, row = id >> 4, ch = id & 15;
          *(LAS bf16x8*)(QL + row * 136 + ch * 8) = LD8(qg + (size_t)row * (PITCH * 2) + ch * 16); } }
    const LAS unsigned short* qrow = QL + r32 * 136 + hi * 8;
    float m_reg = -1e30f, l_reg = 0.f; f32x16 o0[4] = {}, o1[4] = {};
    unsigned gK, gV;
    { const int o = wid * 1024 + lane * 16;
      { const int row = o >> 8, cb = (o & 255) ^ ((row & 7) << 4); gK = (unsigned)(row * (PITCH * 2) + cb); }
      { const int sub = o >> 9, kh = sub >> 2, c5 = sub & 3, rem = (o & 511) >> 1, kk = kh * 8 + (rem >> 5), c = c5 * 32 + (rem & 31);
        const int k = (kk & ~0xC) | ((kk & 4) << 1) | ((kk & 8) >> 1); gV = (unsigned)(k * (PITCH * 2) + c * 2); } }
#define B2_LOAD(t, bf) do { const GAS char* kt_ = uni((const char*)cur.K + (size_t)(32 * (t)) * (PITCH * 2)); const GAS char* vt_ = uni((const char*)cur.V + (size_t)(32 * (t)) * (PITCH * 2)); \
        __builtin_amdgcn_global_load_lds((const GAS unsigned*)(kt_ + gK), (LAS unsigned*)(K_lds + (bf) * 8192 + wid * 1024), 16, 0, 0); \
        __builtin_amdgcn_global_load_lds((const GAS unsigned*)(vt_ + gV), (LAS unsigned*)(V_lds + (bf) * 16384 + wid * 1024), 16, 0, 0); \
        __builtin_amdgcn_global_load_lds((const GAS unsigned*)(vt_ + gV + 256), (LAS unsigned*)(V_lds + (bf) * 16384 + 8192 + wid * 1024), 16, 0, 0); } while (0)
#define B2_TRRD(dst, off) asm volatile("ds_read_b64_tr_b16 %0, %1 offset:%2" : "=&v"(dst) : "v"(vb0), "i"(off) : "memory")
#define B2_RD16(l0, h0, l1, h1, BF, HALF) do { constexpr int b_ = (BF) * 16384 + (HALF) * 8192; \
        B2_TRRD(l0[0], b_); B2_TRRD(h0[0], b_ + 2048); B2_TRRD(l1[0], b_ + 4096); B2_TRRD(h1[0], b_ + 6144); \
        B2_TRRD(l0[1], b_ + 512); B2_TRRD(h0[1], b_ + 512 + 2048); B2_TRRD(l1[1], b_ + 512 + 4096); B2_TRRD(h1[1], b_ + 512 + 6144); \
        B2_TRRD(l0[2], b_ + 1024); B2_TRRD(h0[2], b_ + 1024 + 2048); B2_TRRD(l1[2], b_ + 1024 + 4096); B2_TRRD(h1[2], b_ + 1024 + 6144); \
        B2_TRRD(l0[3], b_ + 1536); B2_TRRD(h0[3], b_ + 1536 + 2048); B2_TRRD(l1[3], b_ + 1536 + 4096); B2_TRRD(h1[3], b_ + 1536 + 6144); } while (0)
#define B2_MM8(oo, l0, h0, l1, h1) do { _Pragma("unroll") for (int d0 = 0; d0 < 4; ++d0) { \
        oo[d0] = __builtin_amdgcn_mfma_f32_32x32x16_bf16(pa0, (bf16x8){l0[d0][0], l0[d0][1], l0[d0][2], l0[d0][3], h0[d0][0], h0[d0][1], h0[d0][2], h0[d0][3]}, oo[d0], 0, 0, 0); \
        oo[d0] = __builtin_amdgcn_mfma_f32_32x32x16_bf16(pa1, (bf16x8){l1[d0][0], l1[d0][1], l1[d0][2], l1[d0][3], h1[d0][0], h1[d0][1], h1[d0][2], h1[d0][3]}, oo[d0], 0, 0, 0); } } while (0)
#define B2_STEP(t, BF) do { \
        if ((t) + 1 < NT) B2_LOAD((t) + 1, (BF) ^ 1);       \
        SBAR(); \
        if (32 * (t) <= qe) { \
            f32x16 p0 = {}; \
            _Pragma("unroll") for (int d0 = 0; d0 < 8; ++d0) { const bf16x8 b0 = *(const LAS bf16x8*)(K_lds + (BF) * 8192 + kb[d0 & 3] + (d0 >> 2) * 128); \
                p0 = __builtin_amdgcn_mfma_f32_32x32x16_bf16(b0, *(const LAS bf16x8*)(qrow + d0 * 16), p0, 0, 0, 0); } \
            float pmax = p0[0]; \
            _Pragma("unroll") for (int r = 1; r < 16; ++r) pmax = fmaxf(pmax, p0[r]); \
            { auto rr = __builtin_amdgcn_permlane32_swap(__float_as_uint(pmax), __float_as_uint(pmax), false, false); pmax = fmaxf(__uint_as_float(rr[0]), __uint_as_float(rr[1])); } \
            float alpha = 1.f; \
            if (!__all((pmax - m_reg) * SCALE <= THR)) { const float mn = fmaxf(m_reg, pmax); alpha = __builtin_amdgcn_exp2f((m_reg - mn) * C2); m_reg = mn; } \
            const float mnL = -m_reg * C2; float ps = 0.f; \
            _Pragma("unroll") for (int r = 0; r < 16; ++r) { p0[r] = __builtin_amdgcn_exp2f(fmaf(p0[r], C2, mnL)); ps += p0[r]; } \
            { auto rr = __builtin_amdgcn_permlane32_swap(__float_as_uint(ps), __float_as_uint(ps), false, false); ps = __uint_as_float(rr[0]) + __uint_as_float(rr[1]); } \
            l_reg = l_reg * alpha + ps; \
            bf16x8 pa0, pa1; \
            { const unsigned a0 = cvtpk(p0[0], p0[1]), a1 = cvtpk(p0[2], p0[3]), b0_ = cvtpk(p0[4], p0[5]), b1_ = cvtpk(p0[6], p0[7]); \
              auto r0 = __builtin_amdgcn_permlane32_swap(a0, b0_, false, false); auto r1 = __builtin_amdgcn_permlane32_swap(a1, b1_, false, false); \
              v4u w = {r0[0], r1[0], r0[1], r1[1]}; pa0 = __builtin_bit_cast(bf16x8, w); } \
            { const unsigned a0 = cvtpk(p0[8], p0[9]), a1 = cvtpk(p0[10], p0[11]), b0_ = cvtpk(p0[12], p0[13]), b1_ = cvtpk(p0[14], p0[15]); \
              auto r0 = __builtin_amdgcn_permlane32_swap(a0, b0_, false, false); auto r1 = __builtin_amdgcn_permlane32_swap(a1, b1_, false, false); \
              v4u w = {r0[0], r1[0], r0[1], r1[1]}; pa1 = __builtin_bit_cast(bf16x8, w); } \
            if (__any(alpha < 1.f)) { if (hi == 0) al_l[r32] = alpha; asm volatile("s_waitcnt lgkmcnt(0)" ::: "memory"); \
                _Pragma("unroll") for (int d_ = 0; d_ < 4; ++d_) _Pragma("unroll") for (int r = 0; r < 16; ++r) { const float f_ = al_l[crow(r, hi)]; o0[d_][r] *= f_; o1[d_][r] *= f_; } \
                asm volatile("s_waitcnt lgkmcnt(0)" ::: "memory"); } \
            SBAR(); \
            { s16x4 al0[4], ah0[4], al1[4], ah1[4], bl0[4], bh0[4], bl1[4], bh1[4]; \
              B2_RD16(al0, ah0, al1, ah1, BF, 0); asm volatile("s_waitcnt lgkmcnt(0)" ::: "memory"); SBAR(); \
              B2_RD16(bl0, bh0, bl1, bh1, BF, 1); SBAR();              \
              B2_MM8(o0, al0, ah0, al1, ah1); SBAR(); \
              asm volatile("s_waitcnt lgkmcnt(0)" ::: "memory"); SBAR(); \
              B2_MM8(o1, bl0, bh0, bl1, bh1); } \
        } \
        SBAR(); \
        VMW(); asm volatile("s_waitcnt lgkmcnt(0)" ::: "memory"); __builtin_amdgcn_s_barrier(); asm volatile("" ::: "memory"); } while (0)
    B2_LOAD(0, 0); VMW();
    __syncthreads();
    for (int t = 0; t < NT; t += 2) { B2_STEP(t, 0); B2_STEP(t + 1, 1); }
    if (hi == 0) li_l[r32] = l_reg; asm volatile("s_waitcnt lgkmcnt(0)" ::: "memory");
    float rli[16];
#pragma unroll
    for (int r = 0; r < 16; ++r) rli[r] = __builtin_amdgcn_rcpf(li_l[crow(r, hi)]);
    GAS char* stb = uni(stash + ((size_t)(blockIdx.x * NWAVES + wid) * ST_PER_LANE) * 64);
    const unsigned sl = (unsigned)lane * 4u;
#define ST_AT(idx) (*(GAS float*)(stb + (size_t)(idx) * 256 + sl))
#define B2_FENCE() do { asm volatile("" ::: "memory"); __builtin_amdgcn_sched_barrier(0); } while (0)
    if (cur.mode == 0) {
#pragma unroll
        for (int d0 = 0; d0 < 4; ++d0) {
#pragma unroll
            for (int r = 0; r < 16; ++r) ST_AT(d0 * 16 + r) = o0[d0][r] * rli[r];
            B2_FENCE();
#pragma unroll
            for (int r = 0; r < 16; ++r) ST_AT(64 + d0 * 16 + r) = o1[d0][r] * rli[r];
            B2_FENCE(); }
    } else {
        float ssp[16];
#pragma unroll
        for (int r = 0; r < 16; ++r) ssp[r] = 0.f;
#pragma unroll
        for (int d0 = 0; d0 < 4; ++d0) {
            { float t2[16];
#pragma unroll
              for (int r = 0; r < 16; ++r) t2[r] = ST_AT(d0 * 16 + r);
#pragma unroll
              for (int r = 0; r < 16; ++r) { const float x = o0[d0][r] * rli[r] - lam * t2[r]; ST_AT(d0 * 16 + r) = x; ssp[r] += x * x; } }
            B2_FENCE();
            { float t3[16];
#pragma unroll
              for (int r = 0; r < 16; ++r) t3[r] = ST_AT(64 + d0 * 16 + r);
#pragma unroll
              for (int r = 0; r < 16; ++r) { const float y = o1[d0][r] * rli[r] - lam * t3[r]; ST_AT(64 + d0 * 16 + r) = y; ssp[r] += y * y; } }
            B2_FENCE(); }
#pragma unroll
        for (int r = 0; r < 16; ++r) { float q = ssp[r]; q += __shfl_xor(q, 1); q += __shfl_xor(q, 2); q += __shfl_xor(q, 4); q += __shfl_xor(q, 8); q += __shfl_xor(q, 16);
            ssp[r] = __builtin_amdgcn_rsqf(q * (1.0f / 256.0f) + EPS) * (1.0f - LAMBDA_INIT); }
        B2_FENCE();
        GAS char* Owb = uni(OB + (size_t)(cur.orow + wid * QBLK) * DM + cur.h * 256);
        const unsigned ol = (unsigned)(4 * hi * DM + r32) * 2u;
#pragma unroll
        for (int half = 0; half < 2; ++half)
#pragma unroll
            for (int d0 = 0; d0 < 4; ++d0) { const float g = subln[half * 128 + d0 * 32 + r32]; float xv[16];
#pragma unroll
                for (int r = 0; r < 16; ++r) xv[r] = ST_AT(half * 64 + d0 * 16 + r);
#pragma unroll
                for (int r = 0; r < 16; ++r) { const unsigned ro = ol + (unsigned)(((r & 3) + 8 * (r >> 2)) * DM + half * 128 + d0 * 32) * 2u;
                    const float v = xv[r] * ssp[r] * g; const float vn = __shfl_xor(v, 1);
                    if ((r32 & 1) == 0) *(GAS unsigned*)(Owb + ro) = cvtpk(v, vn); }
                B2_FENCE(); }
    }
#undef B2_FENCE
#undef ST_AT
    __syncthreads();
#undef B2_LOAD
#undef B2_TRRD
#undef B2_RD16
#undef B2_MM8
#undef B2_STEP
}
__device__ __forceinline__ BlockRef decode2(int k, int c, int G, const bf16* Qb, const bf16* Kb, const bf16* Vb) {
    const int L = c + (k >> 2) * G, sub = k & 3, pass = sub >> 1, m1 = sub & 1, bh = L >> 2, x = L & 3, qb = pass ? 7 - x : x, b = bh >> 3, h = bh & 7;
    const int hv = 2 * h + (m1 ? 0 : 1);
    BlockRef r; r.Q = Qb + (size_t)(b * SEQ + qb * QB) * DM + hv * 128; r.K = Kb + (size_t)(b * SEQ) * DM + hv * 128; r.V = Vb + (size_t)(b * SEQ) * DM + h * 256;
    r.P0 = qb * QB; r.mode = m1; r.orow = b * SEQ + qb * QB; r.h = h; return r;
}

constexpr int SA_ML = 0, SA_FAC = 2048, SA_SSQ = 3072, SA_OBUF = 4096, SA_Q = SA_OBUF + 4 * 32 * 128 * 4;
__device__ __forceinline__ void sample_unit(LAS unsigned char* lds, int s, int h, const Args& a, const bf16* Qb, float* out, bf16* OB, float lam) {
    const int tid = opaque_tid(), wid = __builtin_amdgcn_readfirstlane(tid >> 6), lane = tid & 63, r32 = lane & 31, hi = lane >> 5;
    const int mj = wid >> 2, dh = (wid >> 1) & 1, ks = wid & 1, hv = 2 * h + mj;
    LAS float* ML = (LAS float*)(lds + SA_ML); LAS float* FAC = (LAS float*)(lds + SA_FAC); LAS float* SSQ = (LAS float*)(lds + SA_SSQ); LAS float* OBUF = (LAS float*)(lds + SA_OBUF);
    LAS unsigned short* QL = (LAS unsigned short*)(lds + SA_Q);
    { const int m2 = tid >> 8, row = (tid >> 3) & 31, ch = tid & 7;
#pragma unroll
      for (int p = 0; p < 2; ++p) { const int c8 = (ch + 8 * p) * 8;
          *(LAS v4u*)(QL + (m2 * 32 + row) * 136 + c8) = *(const GAS v4u*)((const GAS bf16*)Qb + (size_t)(MP + DECS * s + row) * DM + (2 * h + m2) * 128 + c8); } }
    LDS_WAIT(); __syncthreads();
    const LAS unsigned short* qrow = QL + (mj * 32 + r32) * 136 + hi * 8;
    float m_reg = -1e30f, l_reg = 0.f; f32x16 o[4] = {};
    const int ntile = ks ? 33 : 32;
    for (int t = 0; t < ntile; ++t) {
        const bool newt = (t == 32);
        const float* Kp = newt ? out + O_K_S + (size_t)(DECS * s) * DM + hv * 128 : a.in[I_CK] + ((size_t)s * PAST + ks * 1024 + t * 32) * DM + hv * 128;
        const float* Vp = newt ? out + O_V_S + (size_t)(DECS * s) * DM + h * 256 + dh * 128 : a.in[I_CV] + ((size_t)s * PAST + ks * 1024 + t * 32) * DM + h * 256 + dh * 128;
        f32x4 kf[8][2]; float vf[2][4][8];
        { const GAS float* kp = (const GAS float*)uni(Kp) + (size_t)r32 * DM + hi * 8;
#pragma unroll
          for (int d0 = 0; d0 < 8; ++d0) { kf[d0][0] = *(const GAS f32x4*)(kp + d0 * 16); kf[d0][1] = *(const GAS f32x4*)(kp + d0 * 16 + 4); }
          const GAS float* vp = (const GAS float*)uni(Vp) + (size_t)(8 * hi) * DM + r32;
#pragma unroll
          for (int k4 = 0; k4 < 2; ++k4)
#pragma unroll
              for (int d0 = 0; d0 < 4; ++d0)
#pragma unroll
                  for (int i = 0; i < 8; ++i) vf[k4][d0][i] = vp[(size_t)(16 * k4 + i) * DM + d0 * 32]; }
        f32x16 p0 = {};
#pragma unroll
        for (int d0 = 0; d0 < 8; ++d0) { const bf16x8 qf = *(const LAS bf16x8*)(qrow + d0 * 16);
            p0 = __builtin_amdgcn_mfma_f32_32x32x16_bf16(pack8(kf[d0][0], kf[d0][1]), qf, p0, 0, 0, 0); }
        float pmax = p0[0];
#pragma unroll
        for (int r = 1; r < 16; ++r) pmax = fmaxf(pmax, p0[r]);
        { auto rr = __builtin_amdgcn_permlane32_swap(__float_as_uint(pmax), __float_as_uint(pmax), false, false); pmax = fmaxf(__uint_as_float(rr[0]), __uint_as_float(rr[1])); }
        float alpha = 1.f;
        if (!__all((pmax - m_reg) * SCALE <= THR)) { const float mn = fmaxf(m_reg, pmax); alpha = __builtin_amdgcn_exp2f((m_reg - mn) * C2); m_reg = mn; }
        const float mnL = -m_reg * C2; float ps = 0.f;
#pragma unroll
        for (int r = 0; r < 16; ++r) { p0[r] = __builtin_amdgcn_exp2f(fmaf(p0[r], C2, mnL)); ps += p0[r]; }
        { auto rr = __builtin_amdgcn_permlane32_swap(__float_as_uint(ps), __float_as_uint(ps), false, false); ps = __uint_as_float(rr[0]) + __uint_as_float(rr[1]); }
        l_reg = l_reg * alpha + ps;
        bf16x8 pa[2];
#pragma unroll
        for (int k4 = 0; k4 < 2; ++k4) { const unsigned a0 = cvtpk(p0[8 * k4 + 0], p0[8 * k4 + 1]), a1 = cvtpk(p0[8 * k4 + 2], p0[8 * k4 + 3]), b0 = cvtpk(p0[8 * k4 + 4], p0[8 * k4 + 5]), b1 = cvtpk(p0[8 * k4 + 6], p0[8 * k4 + 7]);
            auto r0 = __builtin_amdgcn_permlane32_swap(a0, b0, false, false); auto r1 = __builtin_amdgcn_permlane32_swap(a1, b1, false, false);
            v4u w = {r0[0], r1[0], r0[1], r1[1]}; pa[k4] = __builtin_bit_cast(bf16x8, w); }
        if (__any(alpha < 1.f)) { LAS float* al = FAC + wid * 32; if (hi == 0) al[r32] = alpha; asm volatile("s_waitcnt lgkmcnt(0)" ::: "memory");
#pragma unroll
            for (int d_ = 0; d_ < 4; ++d_)
#pragma unroll
                for (int r = 0; r < 16; ++r) o[d_][r] *= al[crow(r, hi)];
            asm volatile("s_waitcnt lgkmcnt(0)" ::: "memory"); }
#pragma unroll
        for (int k4 = 0; k4 < 2; ++k4)
#pragma unroll
            for (int d0 = 0; d0 < 4; ++d0) { const f32x4 lo = {vf[k4][d0][0], vf[k4][d0][1], vf[k4][d0][2], vf[k4][d0][3]}, hi4 = {vf[k4][d0][4], vf[k4][d0][5], vf[k4][d0][6], vf[k4][d0][7]};
                o[d0] = __builtin_amdgcn_mfma_f32_32x32x16_bf16(pa[k4], pack8(lo, hi4), o[d0], 0, 0, 0); }
    }
    if (hi == 0) { ML[(wid * 32 + r32) * 2] = m_reg; ML[(wid * 32 + r32) * 2 + 1] = l_reg; }
    LDS_WAIT(); __syncthreads();
    { const float mp = ML[((wid ^ 1) * 32 + r32) * 2], lp = ML[((wid ^ 1) * 32 + r32) * 2 + 1];
      const float mt = fmaxf(m_reg, mp), fs = __builtin_amdgcn_exp2f((m_reg - mt) * C2), fp = __builtin_amdgcn_exp2f((mp - mt) * C2), lt = l_reg * fs + lp * fp;
      if (hi == 0) FAC[wid * 32 + r32] = fs * __builtin_amdgcn_rcpf(lt); }
    LDS_WAIT();
#pragma unroll
    for (int d0 = 0; d0 < 4; ++d0)
#pragma unroll
        for (int r = 0; r < 16; ++r) o[d0][r] *= FAC[wid * 32 + crow(r, hi)];
    LAS float* ob = OBUF + (size_t)(mj * 2 + dh) * 32 * 128;
    if (ks == 1) {
#pragma unroll
        for (int d0 = 0; d0 < 4; ++d0)
#pragma unroll
            for (int r = 0; r < 16; ++r) ob[crow(r, hi) * 128 + d0 * 32 + r32] = o[d0][r]; }
    LDS_WAIT(); __syncthreads();
    if (ks == 0) {
#pragma unroll
        for (int d0 = 0; d0 < 4; ++d0)
#pragma unroll
            for (int r = 0; r < 16; ++r) o[d0][r] += ob[crow(r, hi) * 128 + d0 * 32 + r32]; }
    LDS_WAIT(); __syncthreads();
    if (ks == 0 && mj == 1) {
#pragma unroll
        for (int d0 = 0; d0 < 4; ++d0)
#pragma unroll
            for (int r = 0; r < 16; ++r) OBUF[(size_t)dh * 32 * 128 + crow(r, hi) * 128 + d0 * 32 + r32] = o[d0][r]; }
    LDS_WAIT(); __syncthreads();
    float ssp[16];
#pragma unroll
    for (int r = 0; r < 16; ++r) ssp[r] = 0.f;
    if (ks == 0 && mj == 0) {
#pragma unroll
        for (int d0 = 0; d0 < 4; ++d0)
#pragma unroll
            for (int r = 0; r < 16; ++r) { const float x = o[d0][r] - lam * OBUF[(size_t)dh * 32 * 128 + crow(r, hi) * 128 + d0 * 32 + r32]; o[d0][r] = x; ssp[r] += x * x; }
#pragma unroll
        for (int r = 0; r < 16; ++r) { float q = ssp[r]; q += __shfl_xor(q, 1); q += __shfl_xor(q, 2); q += __shfl_xor(q, 4); q += __shfl_xor(q, 8); q += __shfl_xor(q, 16);
            if (r32 == 0) SSQ[dh * 32 + crow(r, hi)] = q; } }
    LDS_WAIT(); __syncthreads();
    if (ks == 0 && mj == 0) {
        bf16* Ow = OB + (size_t)(MP + DECS * s) * DM + h * 256 + dh * 128;
#pragma unroll
        for (int r = 0; r < 16; ++r) { const int row = crow(r, hi); ssp[r] = __builtin_amdgcn_rsqf((SSQ[row] + SSQ[32 + row]) * (1.0f / 256.0f) + EPS) * (1.0f - LAMBDA_INIT); }
#pragma unroll
        for (int d0 = 0; d0 < 4; ++d0) { const float g = a.in[I_ATSUBLN][dh * 128 + d0 * 32 + r32];
#pragma unroll
            for (int r = 0; r < 16; ++r) { const float v = o[d0][r] * ssp[r] * g; const float vn = __shfl_xor(v, 1);
                if ((r32 & 1) == 0) *(unsigned*)(Ow + (size_t)crow(r, hi) * DM + d0 * 32 + r32) = cvtpk(v, vn); } } }
    LDS_WAIT(); __syncthreads();
}
#undef ROW
#undef VMW
#undef VMWN
#undef LD8
}

__device__ __forceinline__ void attn_phase(const Ctx& F, const Args& a) {
    const bf16* Qb = (const bf16*)(F.ws + WS_Q); const bf16* Kb = (const bf16*)(F.ws + WS_K); const bf16* Vb = (const bf16*)(F.ws + WS_V); bf16* OB = (bf16*)(F.ws + WS_OB); float* stash = (float*)(F.ws + WS_ST);
    const int lane = opaque_tid() & 63;
    float lam;
    { const float* L = a.in[I_ATLAM]; const float s1 = wave_sum(L[lane] * L[128 + lane] + L[64 + lane] * L[192 + lane]), s2 = wave_sum(L[256 + lane] * L[384 + lane] + L[320 + lane] * L[448 + lane]);
      lam = __expf(s1) - __expf(s2) + LAMBDA_INIT; }
    unsigned* qctr = (unsigned*)(F.ws + WS_CTL) + CW_ATTNQ;
    volatile LAS int* qslot = (volatile LAS int*)(F.lds + MISC_OFF) + 16;
    const int tid0 = opaque_tid();
    for (;;) {
        if (tid0 == 0) *qslot = (int)__hip_atomic_fetch_add(qctr, 1u, __ATOMIC_RELAXED, __HIP_MEMORY_SCOPE_AGENT);
        __syncthreads();
        const int idx = __builtin_amdgcn_readfirstlane(*qslot);
        __syncthreads();
        if (idx >= 1152) break;
        if (idx >= 640 && idx < 768) { const int u = idx - 640; att::sample_unit(F.lds, u >> 3, u & 7, a, Qb, F.out, OB, lam); continue; }
        const int j = idx < 640 ? idx : idx - 128, qb = 7 - (j >> 7), bh = j & 127, b = bh >> 3, h = bh & 7;
#pragma unroll 1
        for (int m1 = 0; m1 < 2; ++m1) { const int hv = 2 * h + (m1 ? 0 : 1);
            att::BlockRef r; r.Q = Qb + (size_t)(b * SEQ + qb * att::QB) * DM + hv * 128; r.K = Kb + (size_t)(b * SEQ) * DM + hv * 128; r.V = Vb + (size_t)(b * SEQ) * DM + h * 256;
            r.P0 = qb * att::QB; r.mode = m1; r.orow = b * SEQ + qb * att::QB; r.h = h;
            att::block2(r, F.lds, lam, a.in[I_ATSUBLN], stash, OB); }
    }
    VM_WAIT(); __syncthreads();
}

#ifndef MK_PH_LO
#define MK_PH_LO 0
#endif
#ifndef MK_PH_HI
#define MK_PH_HI 99
#endif
template <class Epi>
__device__ __forceinline__ void run_gemm(const Ctx& F, const bf16* A, const bf16* Bt, int N, int K, const Epi& E, int M = MT) {
    pg8::Gemm g{A, Bt, M, N, K, K}; pg8::StaticOrder S; S.init(M, N, F.G, (int)blockIdx.x);
    pg8::gemm_phase<Epi, pg8::StaticOrder, PG8_ALIGN, PG8_SP2>(F.lds + RING_OFF, g, S, E);
}
__device__ __forceinline__ void run_resid_gemm(const Ctx& F, const bf16* A, const bf16* Bt, int K, int f, const EpiResid& E) {
    run_gemm(F, A, Bt, DM, K, E, MP);
    const int kc = K / f;
    pg8::Gemm g{A, Bt, MT, DM, kc, K}; pg8::SplitOrder S; S.init(MP / 256, DM, f, kc, F.G, (int)blockIdx.x);
    EpiSlab ES{(float*)(F.ws + WS_SLAB), kc};
    pg8::gemm_phase<EpiSlab, pg8::SplitOrder, PG8_ALIGN, PG8_SP2>(F.lds + RING_OFF, g, S, ES);
}
__device__ __forceinline__ void ffn_layer(const Ctx& F, const Args& a, const XcdBarrier& bar, int layer, const float* ss_in, float* ss_out) {
    bf16* XB = (bf16*)(F.ws + WS_XB); bf16* H = (bf16*)(F.ws + WS_H); float* UE = (float*)(F.ws + WS_UE);
    { EpiFfnUp E{H, UE, ss_in + RS_OFF, a.in[I_FFNCW] + (size_t)layer * 3 * NUP, a.in[I_FFNCB] + (size_t)layer * NUP};
      run_gemm(F, XB, (const bf16*)(F.ws + (layer ? WS_UP1 : WS_UP0)), NUP, DM, E); }
    xcd_barrier(bar);
    ffn_fixup(F, a, layer);
    xcd_barrier(bar);
    { EpiResid E{F.out, F.out + (size_t)MP * DM, F.out, XB, ss_out};
      run_resid_gemm(F, H, (const bf16*)(F.ws + (layer ? WS_DN1 : WS_DN0)), DFF, 11, E); }
    xcd_barrier(bar);
    resid_finish(F, F.out + (size_t)MP * DM, 11, ss_out);
    xcd_barrier(bar);
}
__global__ void __launch_bounds__(NWAVES * 64, 2) mk_fwd(Args args) {
    extern __shared__ __attribute__((aligned(16))) unsigned char lds_raw[];
    Ctx F;
    F.lds = (LAS unsigned char*)lds_raw; F.ws = args.ws; F.out = args.out;
    F.G = gridDim.x; { const int bx = blockIdx.x; F.vcu = (F.G % 8 == 0) ? (bx % 8) * (F.G / 8) + bx / 8 : bx; }
    volatile LAS unsigned* MISC = (volatile LAS unsigned*)(F.lds + MISC_OFF);
    for (int u = threadIdx.x; u < (LDS_BYTES - LDSCTL_OFF) / 4; u += NWAVES * 64) ((LAS unsigned*)(F.lds + LDSCTL_OFF))[u] = 0u;
    __syncthreads();
    XcdBarrier bar = xcd_barrier_post((unsigned*)(F.ws + WS_CTL) + CW_BAR, MISC + 8);
    bf16* XB = (bf16*)(F.ws + WS_XB);
    float* SS0 = (float*)(F.ws + WS_SS), *SS1 = (float*)(F.ws + WS_SS + SS_STRIDE), *SS2 = (float*)(F.ws + WS_SS + 2 * SS_STRIDE), *SS3 = (float*)(F.ws + WS_SS + 3 * SS_STRIDE), *SS4 = (float*)(F.ws + WS_SS + 4 * SS_STRIDE);

#ifndef PHM
#define PHM 0xffff
#endif
#ifndef REP_P0
#define REP_P0 1
#endif
#ifndef REP_P2
#define REP_P2 1
#endif
#ifndef REP_P7
#define REP_P7 1
#endif
    for (int rep = 0; rep < REP_P0; ++rep) { if (rep) { VM_WAIT(); __syncthreads(); } p0_prologue(F, args); }
    xcd_barrier(bar);
#ifndef REP_P1
#define REP_P1 1
#endif
    for (int rep = 0; rep < REP_P1; ++rep) { if (rep) { VM_WAIT(); __syncthreads(); } EpiWin E{(bf16*)(F.ws + WS_U), SS0 + RS_OFF}; run_gemm(F, XB, (const bf16*)(F.ws + WS_WIN), 4096, DM, E); }
    xcd_barrier(bar);
    for (int rep = 0; rep < REP_P2; ++rep) { if (rep) { VM_WAIT(); __syncthreads(); } rglru_phase(F, args); }
    xcd_barrier(bar);
    if constexpr (PHM & 8) { EpiResid E{args.in[I_XP], args.in[I_XS], F.out, XB, SS1}; run_resid_gemm(F, (const bf16*)(F.ws + WS_HY), (const bf16*)(F.ws + WS_RGO), DM, 8, E); }
    xcd_barrier(bar);
    resid_finish(F, args.in[I_XS], 8, SS1);
    xcd_barrier(bar);
    if constexpr (PHM & 16) ffn_layer(F, args, bar, 0, SS1, SS2);
    if constexpr (PHM & 32) { EpiQkv E{(bf16*)(F.ws + WS_Q), (bf16*)(F.ws + WS_K), (bf16*)(F.ws + WS_V), F.out, SS2 + RS_OFF}; run_gemm(F, XB, (const bf16*)(F.ws + WS_QKV), NQKV, DM, E); }
    xcd_barrier(bar);
    for (int rep = 0; rep < REP_P7; ++rep) { if (rep) { VM_WAIT(); __syncthreads(); } attn_phase(F, args); }
    xcd_barrier(bar);
    if constexpr (PHM & 128) { EpiResid E{F.out, F.out + (size_t)MP * DM, F.out, XB, SS3}; run_resid_gemm(F, (const bf16*)(F.ws + WS_OB), (const bf16*)(F.ws + WS_ATO), DM, 8, E); }
    xcd_barrier(bar);
    resid_finish(F, F.out + (size_t)MP * DM, 8, SS3);
    xcd_barrier(bar);
    if constexpr (PHM & 256) ffn_layer(F, args, bar, 1, SS3, SS4);
    if constexpr (PHM & 512) final_norm(F, args, SS4);
}

extern "C" void kernel_launch(void* const* d_in, const int* in_sizes, int n_in, void* d_out, int out_size, void* d_ws, size_t ws_size, hipStream_t stream) {
    static int grid = 0;
    if (grid == 0) {
        if (n_in != 26 || in_sizes[0] != MP * DM || (size_t)out_size != O_END || ws_size < WS_END) {
            fprintf(stderr, "kernel_launch: shape mismatch (n_in %d, in0 %d, out %d, ws %zu; need ws >= %zu); nothing launched\n", n_in, n_in > 0 ? in_sizes[0] : -1, out_size, ws_size, (size_t)WS_END); grid = -1; return; }
        int dev = 0, cus = 0, per_cu = 0;
        if (hipGetDevice(&dev) != hipSuccess || hipDeviceGetAttribute(&cus, hipDeviceAttributeMultiprocessorCount, dev) != hipSuccess) { fprintf(stderr, "kernel_launch: device query failed\n"); grid = -1; return; }
        if (hipFuncSetAttribute((const void*)mk_fwd, hipFuncAttributeMaxDynamicSharedMemorySize, LDS_BYTES) != hipSuccess) { fprintf(stderr, "kernel_launch: hipFuncSetAttribute failed\n"); grid = -1; return; }
        if (hipOccupancyMaxActiveBlocksPerMultiprocessor(&per_cu, (const void*)mk_fwd, NWAVES * 64, LDS_BYTES) != hipSuccess || per_cu < 1)
            fprintf(stderr, "kernel_launch: note: occupancy query reports %d workgroups per CU\n", per_cu);
        (void)hipGetLastError();
        grid = cus;
    }
    if (grid < 0) return;
    if (hipMemsetAsync((char*)d_ws + WS_CTL, 0, CTL_ZERO_BYTES, stream) != hipSuccess) { fprintf(stderr, "kernel_launch: memset failed\n"); return; }
    Args a{};
    for (int i = 0; i < 26; ++i) a.in[i] = (const float*)d_in[i];
    a.out = (float*)d_out; a.ws = (unsigned char*)d_ws;
    hipLaunchKernelGGL(mk_fwd, dim3(grid), dim3(NWAVES * 64), LDS_BYTES, stream, a);
    const hipError_t le = hipPeekAtLastError();
    if (le != hipSuccess) fprintf(stderr, "kernel_launch: launch failed: %s\n", hipGetErrorName(le));
}
```

```cpp
#include <hip/hip_runtime.h>
#include <hip/hip_bf16.h>
#include <cstdio>
#include <cstdint>

namespace pg8 {
#define PG8_LAS __attribute__((address_space(3)))
typedef unsigned short bf16_t;
typedef short bf16x8 __attribute__((ext_vector_type(8)));
typedef float f32x4 __attribute__((ext_vector_type(4)));
typedef unsigned u32x4 __attribute__((ext_vector_type(4)));
constexpr int BM = 256, BK = 64, HALF = 128, HTB = HALF * BK * 2  , STAGE_BYTES = 8 * HTB, NXCD = 8, WGM = 4;

__host__ __device__ __forceinline__ int lds_byte(int r, int c) { const int st = (r >> 4) * 2 + (c >> 5), rr = r & 15, cc = c & 31, ob = rr * 64 + cc * 2; return st * 1024 + (ob ^ (((ob >> 9) & 1) << 5)); }
__host__ __device__ __forceinline__ void stage_rc(int b, int& R, int& C) { const int st = b / 1024, sb = b % 1024, swz = sb ^ (((sb >> 9) & 1) << 5); R = (st >> 1) * 16 + swz / 64; C = (st & 1) * 32 + (swz % 64) / 2; }
__host__ __device__ __forceinline__ int perm32(int rho) { const int n = rho >> 4, i = rho & 15; return 8 * (i >> 2) + 4 * n + (i & 3); }

struct Unit { int pm, pn, ko; };
struct Gemm { const bf16_t* A; const bf16_t* Bt; int M, N, K, ldk; };

struct StaticOrder {
    int nM, nN, nwg, G, c;
    __host__ __device__ void init(int M, int N, int G_, int c_) { nM = M / BM; nN = N / BM; nwg = nM * nN; G = G_; c = c_; }
    __host__ __device__ bool next(int i, Unit& u) const {
        const long L = (long)i * G + c; if (L >= nwg) return false;
        int wgid = (int)L; { const int q = nwg / NXCD, r = nwg % NXCD, xcd = wgid % NXCD, off = wgid / NXCD; wgid = (xcd < r ? xcd * (q + 1) : r * (q + 1) + (xcd - r) * q) + off; }
        const int nig = WGM * nN, gid = wgid / nig, fm = gid * WGM, gsz = (nM - fm) < WGM ? (nM - fm) : WGM;
        u.pm = fm + ((wgid % nig) % gsz); u.pn = (wgid % nig) / gsz; u.ko = 0; return true;
    }
    __device__ __forceinline__ void a_ready(const Unit&) const {}
    __device__ __forceinline__ void done(const Unit&) const {}
};
struct SplitOrder {
    int pm0, nN, f, kc, total, G, c;
    __host__ __device__ void init(int pm0_, int N, int f_, int kc_, int G_, int c_) { pm0 = pm0_; nN = N / BM; f = f_; kc = kc_; total = 2 * nN * f; G = G_; c = c_; }
    __host__ __device__ bool next(int i, Unit& u) const { const int L = i * G + c; if (L >= total) return false; const int ks = L % f, r = L / f; u.pn = r % nN; u.pm = pm0 + r / nN; u.ko = ks * kc; return true; }
    __device__ __forceinline__ void a_ready(const Unit&) const {}
    __device__ __forceinline__ void done(const Unit&) const {}
};

struct TailOrder {
    int pm0, nN, f, kc, ntile, G, c;
    __host__ __device__ void init(int pm0_, int N, int f_, int kc_, int G_, int c_) { pm0 = pm0_; nN = N / BM; f = f_; kc = kc_; ntile = 2 * nN; G = G_; c = c_; }
    __host__ __device__ bool next(int i, Unit& u) const { const int L = i * G + c, nw = ntile * (f - 1); if (L >= ntile * f) return false;
        const int tile = L < nw ? L / (f - 1) : L - nw, ks = L < nw ? L % (f - 1) : f - 1; u.pm = pm0 + tile / nN; u.pn = tile % nN; u.ko = ks * kc; return true; }
    __device__ __forceinline__ void a_ready(const Unit&) const {}
    __device__ __forceinline__ void done(const Unit&) const {}
};

struct OneUnit { Unit u;
    __host__ __device__ bool next(int i, Unit& o) const { if (i > 0) return false; o = u; return true; }
    __device__ __forceinline__ void a_ready(const Unit&) const {}
    __device__ __forceinline__ void done(const Unit&) const {}
};
template <class Epi, class Sched, bool ALIGN_EPI = false, bool SP2 = false, bool SINGLE = false>
__device__ __forceinline__ void gemm_phase(PG8_LAS unsigned char* lds, const Gemm g, const Sched& S, const Epi& E) {
    int tid = threadIdx.x; asm volatile("" : "+v"(tid));
    const int wid = __builtin_amdgcn_readfirstlane(tid >> 6), lane = tid & 63, wr = wid >> 2, wc = wid & 3, fr = lane & 15, fq = lane >> 4;
    const int K = g.ldk, nt = g.K / BK;
    unsigned voffA[2], voffB[2];
#pragma unroll
    for (int i = 0; i < 2; ++i) { int R, C; stage_rc(tid * 16 + i * 8192, R, C); const int Rb = Epi::PERM ? ((R & ~31) + perm32(R & 31)) : R;
        voffA[i] = (unsigned)(R * K + C) * 2u; voffB[i] = (unsigned)(Rb * K + C) * 2u; }
    const size_t kstep = (size_t)(BK * 2);
    const size_t hstep = (size_t)HALF * K * 2;
    const size_t tstep = 2 * hstep;
    const unsigned ldsw = (unsigned)wid * 1024u;
    const int aoff = lds_byte(wr * 64 + fr, fq * 8), boff = lds_byte(wc * 32 + fr, fq * 8);
#define PG8_SA(b, h) (((b) * 2 + (h)) * HTB)
#define PG8_SB(b, h) ((4 + (b) * 2 + (h)) * HTB)
#define PG8_STAGE(bufoff, gbase, voff) do { _Pragma("unroll") for (int _i = 0; _i < 2; ++_i) \
        __builtin_amdgcn_global_load_lds((const unsigned*)((const char*)(gbase) + (voff)[_i]), (PG8_LAS unsigned*)(lds + (bufoff) + ldsw + _i * 8192), 16, 0, 0); } while (0)
#define PG8_LDA(dst, b, h) do { _Pragma("unroll") for (int m = 0; m < 4; ++m) _Pragma("unroll") for (int k = 0; k < 2; ++k) dst[m][k] = *(const PG8_LAS bf16x8*)(lds + PG8_SA(b, h) + aoff + m * 2048 + k * 1024); } while (0)
#define PG8_LDB(dst, b, h) do { _Pragma("unroll") for (int n = 0; n < 2; ++n) _Pragma("unroll") for (int k = 0; k < 2; ++k) dst[n][k] = *(const PG8_LAS bf16x8*)(lds + PG8_SB(b, h) + boff + n * 2048 + k * 1024); } while (0)
#define PG8_MMA(ai, bj, At, Bt) do { __builtin_amdgcn_s_setprio(1); _Pragma("unroll") for (int m = 0; m < 4; ++m) _Pragma("unroll") for (int n = 0; n < 2; ++n) _Pragma("unroll") for (int k = 0; k < 2; ++k) \
        acc[ai][bj][m][n] = __builtin_amdgcn_mfma_f32_16x16x32_bf16(Bt[n][k], At[m][k], acc[ai][bj][m][n], 0, 0, 0); __builtin_amdgcn_s_setprio(0); } while (0)
#define PG8_WAIT_V(n) asm volatile("s_waitcnt vmcnt(" #n ")" ::: "memory")
#define PG8_WAIT_L(n) asm volatile("s_waitcnt lgkmcnt(" #n ")" ::: "memory")
#define PG8_BAR __builtin_amdgcn_s_barrier()
#define PG8_SCHED __builtin_amdgcn_sched_barrier(0)
    Unit cur, nxt; int ui = 0;
    if (!S.next(0, cur)) return;
    f32x4 acc[2][2][4][2];
#pragma unroll
    for (int a = 0; a < 2; ++a)
#pragma unroll
        for (int b = 0; b < 2; ++b)
#pragma unroll
            for (int m = 0; m < 4; ++m)
#pragma unroll
                for (int n = 0; n < 2; ++n) acc[a][b][m][n] = (f32x4){0.f, 0.f, 0.f, 0.f};
    bf16x8 At[4][2], B0[2][2], B1[2][2];
    const char* cA = (const char*)g.A + (size_t)cur.pm * tstep + (size_t)cur.ko * 2; const char* cB = (const char*)g.Bt + (size_t)cur.pn * tstep + (size_t)cur.ko * 2;
    S.a_ready(cur);
    if constexpr (SP2) {
        PG8_STAGE(PG8_SB(0, 0), cB, voffB); PG8_STAGE(PG8_SB(0, 1), cB + hstep, voffB); PG8_STAGE(PG8_SA(0, 0), cA, voffA); PG8_STAGE(PG8_SA(0, 1), cA + hstep, voffA);
        if (wr == 1) PG8_BAR;
        PG8_WAIT_V(2); PG8_BAR;
        PG8_STAGE(PG8_SB(1, 0), cB + kstep, voffB); PG8_STAGE(PG8_SA(1, 0), cA + kstep, voffA); PG8_STAGE(PG8_SB(1, 1), cB + hstep + kstep, voffB);
        PG8_WAIT_V(6); PG8_BAR;
    } else {
        PG8_STAGE(PG8_SB(0, 0), cB, voffB); PG8_STAGE(PG8_SA(0, 0), cA, voffA); PG8_STAGE(PG8_SB(0, 1), cB + hstep, voffB); PG8_STAGE(PG8_SA(0, 1), cA + hstep, voffA);
        if (wr == 1) PG8_BAR;
        PG8_WAIT_V(4); PG8_BAR;
        PG8_STAGE(PG8_SB(1, 0), cB + kstep, voffB); PG8_STAGE(PG8_SA(1, 0), cA + kstep, voffA); PG8_STAGE(PG8_SB(1, 1), cB + hstep + kstep, voffB);
        PG8_WAIT_V(6); PG8_BAR;
    }
    for (;;) {
        const bool has_next = SINGLE ? false : S.next(ui + 1, nxt);
        PG8_LAS unsigned char* const ep = lds + 8 * HTB + (ui & 1) * 5120;
        if constexpr (Epi::PRE) E.prefetch(ep, cur, wid, lane);
        const char* nA = has_next ? (const char*)g.A + (size_t)nxt.pm * tstep + (size_t)nxt.ko * 2 : cA; const char* nB = has_next ? (const char*)g.Bt + (size_t)nxt.pn * tstep + (size_t)nxt.ko * 2 : cB;
        for (int t = 0; t < nt; t += 2) {
            const bool last = (t == nt - 2);
            const char* a1 = cA + (size_t)(t + 1) * kstep;
            const char* a2 = last ? nA : cA + (size_t)(t + 2) * kstep; const char* b2 = last ? nB : cB + (size_t)(t + 2) * kstep;
            const char* a3 = a2 + kstep; const char* b3 = b2 + kstep;
            if (last && has_next) S.a_ready(nxt);
            if constexpr (SP2) {
            PG8_LDB(B0, 0, 0); PG8_LDB(B1, 0, 1); PG8_SCHED; PG8_LDA(At, 0, 0); PG8_STAGE(PG8_SA(1, 1), a1 + hstep, voffA);
            PG8_WAIT_V(8); PG8_WAIT_L(0); PG8_BAR; PG8_MMA(0, 0, At, B0); PG8_MMA(0, 1, At, B1); PG8_BAR; PG8_SCHED;
            PG8_LDA(At, 0, 1); PG8_STAGE(PG8_SB(0, 0), b2, voffB); PG8_STAGE(PG8_SB(0, 1), b2 + hstep, voffB); PG8_STAGE(PG8_SA(0, 0), a2, voffA);
            PG8_WAIT_V(8); PG8_WAIT_L(0); PG8_BAR; PG8_MMA(1, 0, At, B0); PG8_MMA(1, 1, At, B1); PG8_BAR; PG8_SCHED;
            PG8_LDB(B0, 1, 0); PG8_LDB(B1, 1, 1); PG8_SCHED; PG8_LDA(At, 1, 0); PG8_STAGE(PG8_SA(0, 1), a2 + hstep, voffA);
            PG8_WAIT_V(8); PG8_WAIT_L(0); PG8_BAR; PG8_MMA(0, 0, At, B0); PG8_MMA(0, 1, At, B1); PG8_BAR; PG8_SCHED;
            PG8_LDA(At, 1, 1); PG8_STAGE(PG8_SB(1, 0), b3, voffB); PG8_STAGE(PG8_SB(1, 1), b3 + hstep, voffB); PG8_STAGE(PG8_SA(1, 0), a3, voffA);
            PG8_WAIT_V(8); PG8_WAIT_L(0); PG8_BAR; PG8_MMA(1, 0, At, B0); PG8_MMA(1, 1, At, B1); PG8_BAR; PG8_SCHED;
            } else {
            PG8_LDB(B0, 0, 0); PG8_SCHED; PG8_LDA(At, 0, 0); PG8_STAGE(PG8_SA(1, 1), a1 + hstep, voffA);
            PG8_WAIT_L(8); PG8_BAR; PG8_WAIT_L(0); PG8_MMA(0, 0, At, B0); PG8_BAR; PG8_SCHED;
            PG8_LDB(B1, 0, 1); PG8_STAGE(PG8_SB(0, 0), b2, voffB);
            PG8_BAR; PG8_WAIT_L(0); PG8_MMA(0, 1, At, B1); PG8_BAR;
            PG8_LDA(At, 0, 1); PG8_STAGE(PG8_SA(0, 0), a2, voffA);
            PG8_BAR; PG8_WAIT_L(0); PG8_MMA(1, 0, At, B0); PG8_BAR; PG8_SCHED;
            PG8_STAGE(PG8_SB(0, 1), b2 + hstep, voffB);
            PG8_WAIT_V(6); PG8_BAR; PG8_MMA(1, 1, At, B1); PG8_BAR;
            PG8_LDB(B0, 1, 0); PG8_SCHED; PG8_LDA(At, 1, 0); PG8_STAGE(PG8_SA(0, 1), a2 + hstep, voffA);
            PG8_WAIT_L(8); PG8_BAR; PG8_WAIT_L(0); PG8_MMA(0, 0, At, B0); PG8_BAR; PG8_SCHED;
            PG8_LDB(B1, 1, 1); PG8_STAGE(PG8_SB(1, 0), b3, voffB);
            PG8_BAR; PG8_WAIT_L(0); PG8_MMA(0, 1, At, B1); PG8_BAR;
            PG8_LDA(At, 1, 1); PG8_STAGE(PG8_SA(1, 0), a3, voffA);
            PG8_BAR; PG8_WAIT_L(0); PG8_MMA(1, 0, At, B0); PG8_BAR; PG8_SCHED;
            PG8_STAGE(PG8_SB(1, 1), b3 + hstep, voffB);
            PG8_WAIT_V(6); PG8_BAR; PG8_MMA(1, 1, At, B1); PG8_BAR;
            }
        }
        if constexpr (ALIGN_EPI) { if (wr == 0) PG8_BAR; }
        E(acc, cur, wr, wc, fr, fq, ep); S.done(cur);
        if (!has_next) break;
#pragma unroll
        for (int a = 0; a < 2; ++a)
#pragma unroll
            for (int b = 0; b < 2; ++b)
#pragma unroll
                for (int m = 0; m < 4; ++m)
#pragma unroll
                    for (int n = 0; n < 2; ++n) acc[a][b][m][n] = (f32x4){0.f, 0.f, 0.f, 0.f};
        cur = nxt; cA = nA; cB = nB; ++ui;
        if constexpr (ALIGN_EPI) { if (wr == 1) PG8_BAR; }
    }
    PG8_WAIT_V(0);
    if constexpr (!ALIGN_EPI) { if (wr == 0) PG8_BAR; }
    PG8_BAR;
#undef PG8_SA
#undef PG8_SB
#undef PG8_STAGE
#undef PG8_LDA
#undef PG8_LDB
#undef PG8_MMA
#undef PG8_WAIT_V
#undef PG8_WAIT_L
#undef PG8_BAR
#undef PG8_SCHED
}
}

#ifndef PG8_SP2
#define PG8_SP2 true
#endif
#ifndef PG8_ALIGN
#define PG8_ALIGN true
#endif

constexpr int DM = 2048, NBATCH = 16, SEQ = 2048, DECB = 16, DECS = 32, PAST = 2048;
constexpr int MP = NBATCH * SEQ, MS = DECB * DECS, MT = MP + MS;
constexpr int DFF = 5632, NUP = 2 * DFF, NQKV = 3 * DM;
constexpr int NWAVES = 8;
constexpr float EPS = 1e-6f;
constexpr float LAMBDA_INIT = 0.35550906759f;
constexpr size_t O_Y = 0;
constexpr size_t O_RGC_P = (size_t)MT * DM;
constexpr size_t O_RGH_P = O_RGC_P + 16 * 3 * 2048;
constexpr size_t O_K_P = O_RGH_P + 16 * 2048;
constexpr size_t O_V_P = O_K_P + (size_t)MP * DM;
constexpr size_t O_FFN_P = O_V_P + (size_t)MP * DM;
constexpr size_t O_RGC_S = O_FFN_P + 2 * 16 * 2 * NUP;
constexpr size_t O_RGH_S = O_RGC_S + 16 * 3 * 2048;
constexpr size_t O_K_S = O_RGH_S + 16 * 2048;
constexpr size_t O_V_S = O_K_S + (size_t)MS * DM;
constexpr size_t O_FFN_S = O_V_S + (size_t)MS * DM;
constexpr size_t O_END = O_FFN_S + 2 * 16 * 2 * NUP;
static_assert(O_END == 206176256ull && O_V_P - O_K_P == (size_t)MP * DM && O_V_S - O_K_S == (size_t)MS * DM, "d_out size");

constexpr size_t MiB = 1u << 20;
constexpr size_t WS_CTL = 0, CTL_ZERO_BYTES = 1 * MiB;
constexpr size_t WS_WIN = 2 * MiB, WS_RGO = 18 * MiB, WS_QKV = 26 * MiB, WS_ATO = 50 * MiB, WS_UP0 = 58 * MiB, WS_UP1 = 102 * MiB, WS_DN0 = 146 * MiB, WS_DN1 = 168 * MiB, WS_GW = 190 * MiB;
constexpr size_t WS_SS = 192 * MiB, SS_STRIDE = 5 * MiB;
constexpr size_t WS_XB = 218 * MiB;
constexpr size_t WS_BIG = 348 * MiB;
constexpr size_t WS_U = WS_BIG, WS_HY = WS_BIG + 260 * MiB;
constexpr size_t WS_H = WS_BIG, WS_UE = WS_BIG + 358 * MiB;
constexpr size_t WS_Q = WS_BIG, WS_K = WS_BIG + 130 * MiB, WS_V = WS_BIG + 260 * MiB, WS_OB = WS_BIG + 390 * MiB, WS_ST = WS_BIG + 520 * MiB;
constexpr size_t WS_SLAB = WS_BIG + 600 * MiB;
constexpr size_t WS_END = WS_SLAB + 48 * MiB;
constexpr int NCB = 528;
constexpr int ST_PER_LANE = 144;
static_assert((size_t)MT * DFF * 2 <= 358 * MiB && (size_t)NCB * 4 * NUP * 4 <= 100 * MiB && (size_t)256 * 512 * ST_PER_LANE * 4 <= 80 * MiB, "ws map");
constexpr size_t RS_OFF = (size_t)MT * 32;
static_assert((size_t)MT * 33 * 4 <= SS_STRIDE, "rs behind ss");
static_assert((size_t)MT * 32 * 4 <= SS_STRIDE && WS_SS + 5 * SS_STRIDE <= WS_XB && WS_XB + (size_t)MT * DM * 2 <= WS_BIG, "ws map 2");
constexpr int CW_BAR = 4096, CW_ATTNQ = 16384, CW_TAIL = 32768;

constexpr int RING_OFF = 0, RING_BYTES = 131072;
constexpr int LDS_BYTES = 147456;
constexpr int LDSCTL_OFF = LDS_BYTES - 512, MISC_OFF = LDSCTL_OFF + 320;

#define GAS __attribute__((address_space(1)))
#define LAS __attribute__((address_space(3)))
typedef unsigned short bf16;
typedef unsigned v4u __attribute__((ext_vector_type(4)));
typedef unsigned v2u __attribute__((ext_vector_type(2)));
typedef float f32x4 __attribute__((ext_vector_type(4)));
typedef float f32x2 __attribute__((ext_vector_type(2)));
typedef float f32x16 __attribute__((ext_vector_type(16)));
typedef short bf16x8 __attribute__((ext_vector_type(8)));
typedef short s16x4 __attribute__((ext_vector_type(4)));
#define LDS_WAIT() asm volatile("s_waitcnt lgkmcnt(0)" ::: "memory")
#define VM_WAIT() asm volatile("s_waitcnt vmcnt(0)" ::: "memory")
__device__ __forceinline__ unsigned cvtpk(float lo, float hi) { unsigned r; asm volatile("v_cvt_pk_bf16_f32 %0, %1, %2" : "=v"(r) : "v"(lo), "v"(hi)); return r; }
__device__ __forceinline__ float bf2f(unsigned short h) { return __builtin_bit_cast(float, (unsigned)h << 16); }
__device__ __forceinline__ bf16x8 pack8(f32x4 a, f32x4 b) { v4u w = {cvtpk(a[0], a[1]), cvtpk(a[2], a[3]), cvtpk(b[0], b[1]), cvtpk(b[2], b[3])}; return __builtin_bit_cast(bf16x8, w); }
__device__ __forceinline__ float wave_sum(float v) {
#pragma unroll
    for (int o = 1; o < 64; o <<= 1) v += __shfl_xor(v, o);
    return v;
}
__device__ __forceinline__ float gelu_tanh(float x) {
    const float z = x * (0.7978845608f + 0.0356774081f * x * x);
    const float e = __builtin_amdgcn_exp2f(z * -2.885390082f);
    return x * __builtin_amdgcn_rcpf(1.0f + e);
}
__device__ __forceinline__ float sigmoidf_(float x) { return __builtin_amdgcn_rcpf(1.0f + __builtin_amdgcn_exp2f(x * -1.4426950409f)); }
#define FMAC_DPP(c, s, w, CTRL) asm("v_fmac_f32_dpp %0, %1, %2 " CTRL " row_mask:0xf bank_mask:0xf bound_ctrl:1" : "+v"(c) : "v"(s), "v"(w))
__device__ __forceinline__ f32x4 gelu4(f32x4 x) {
    const f32x4 p = (x * x) * -0.10294324f + -2.302208198f;
    const f32x4 q = x * p;
    f32x4 e; e[0] = __builtin_amdgcn_exp2f(q[0]); e[1] = __builtin_amdgcn_exp2f(q[1]); e[2] = __builtin_amdgcn_exp2f(q[2]); e[3] = __builtin_amdgcn_exp2f(q[3]);
    const f32x4 d = e + 1.0f;
    f32x4 r; r[0] = __builtin_amdgcn_rcpf(d[0]); r[1] = __builtin_amdgcn_rcpf(d[1]); r[2] = __builtin_amdgcn_rcpf(d[2]); r[3] = __builtin_amdgcn_rcpf(d[3]);
    return x * r;
}
__device__ __forceinline__ f32x4 gelu4_mul(f32x4 x, f32x4 v) {
    const f32x4 p = (x * x) * -0.10294324f + -2.302208198f;
    const f32x4 q = x * p;
    f32x4 e; e[0] = __builtin_amdgcn_exp2f(q[0]); e[1] = __builtin_amdgcn_exp2f(q[1]); e[2] = __builtin_amdgcn_exp2f(q[2]); e[3] = __builtin_amdgcn_exp2f(q[3]);
    const f32x4 d = e + 1.0f;
    f32x4 r; r[0] = __builtin_amdgcn_rcpf(d[0]); r[1] = __builtin_amdgcn_rcpf(d[1]); r[2] = __builtin_amdgcn_rcpf(d[2]); r[3] = __builtin_amdgcn_rcpf(d[3]);
    return (x * v) * r;
}
#define DPP_F(oldv, src, ctrl, bc) __builtin_bit_cast(float, __builtin_amdgcn_update_dpp(__builtin_bit_cast(int, (float)(oldv)), __builtin_bit_cast(int, (float)(src)), (ctrl), 0xf, 0xf, (bc)))

__device__ __forceinline__ int opaque_tid() { int t = threadIdx.x; asm volatile("" : "+v"(t)); return t; }
#define XB_TMO      128
#define XB_XCNT(j)  (256  + 64 * (j))
#define XB_XSUB(j)  (1280 + 64 * (j))
#define XB_XGEN(j)  (2304 + 64 * (j))
#define XB_TOP      3328
#define XB_TOPGEN   3392
#define XCD_BAR_WORDS 3456
#define XB_SPIN_CAP (1u << 18)

__device__ __forceinline__ unsigned xb_ld(unsigned* p)              { return __hip_atomic_load(p, __ATOMIC_RELAXED, __HIP_MEMORY_SCOPE_AGENT); }
__device__ __forceinline__ unsigned xb_add(unsigned* p, unsigned v) { return __hip_atomic_fetch_add(p, v, __ATOMIC_RELAXED, __HIP_MEMORY_SCOPE_AGENT); }
__device__ __forceinline__ unsigned xb_xcc_id() { return (unsigned)__builtin_amdgcn_s_getreg((3 << 11) | 20) & 0xFu; }
#define XB_SPIN(cond, bar) do { unsigned _sp = 0; while (cond) { __builtin_amdgcn_s_sleep(1); \
    if ((++_sp & 255u) == 0u) { if (xb_ld(&(bar)[XB_TMO])) break; if (_sp > XB_SPIN_CAP) { atomicAdd(&(bar)[XB_TMO], 1u); break; } } } } while (0)

struct XcdBarrier {
    unsigned* bar; unsigned x;
    volatile LAS unsigned* st;
};
__device__ __forceinline__ XcdBarrier xcd_barrier_post(unsigned* bar, volatile LAS unsigned* st) {
    XcdBarrier b; b.bar = bar; b.x = xb_xcc_id(); b.st = st;
    if (threadIdx.x == 0) (void)xb_add(&bar[XB_XCNT(b.x)], 1u);
    return b;
}
__device__ __forceinline__ void xcd_barrier_complete(unsigned* bar, unsigned x, unsigned& nloc, unsigned& nx) {
    const unsigned G = gridDim.x * gridDim.y * gridDim.z;
    unsigned sum, cnt, mine, sp = 0u;
    for (;;) {
        sum = 0u; cnt = 0u; mine = 0u;
#pragma unroll
        for (unsigned j = 0; j < 16; ++j) { const unsigned c = xb_ld(&bar[XB_XCNT(j)]); sum += c; cnt += (c > 0u) ? 1u : 0u; mine = (j == x) ? c : mine; }
        if (sum == G) break;
        __builtin_amdgcn_s_sleep(1);
        if ((++sp & 255u) == 0u) { if (xb_ld(&bar[XB_TMO])) break; if (sp > XB_SPIN_CAP) { atomicAdd(&bar[XB_TMO], 1u); break; } }
    }
    nloc = mine > 0u ? mine : 1u; nx = cnt > 0u ? cnt : 1u;
}
__device__ __forceinline__ void xcd_barrier(const XcdBarrier& b) {
    asm volatile("s_waitcnt vmcnt(0)" ::: "memory");
    __syncthreads();
    if (threadIdx.x == 0) {
        unsigned* bar = b.bar;
        __builtin_amdgcn_s_waitcnt(0);
        unsigned nloc = b.st[0], nx = b.st[1];
        if (nloc == 0u) { xcd_barrier_complete(bar, b.x, nloc, nx); b.st[0] = nloc; b.st[1] = nx; }
        const unsigned old = xb_add(&bar[XB_XSUB(b.x)], 1u);
        const unsigned gen = old / nloc;
        if (old + 1u == (gen + 1u) * nloc) {
            __builtin_amdgcn_fence(__ATOMIC_RELEASE, "agent");
            asm volatile("s_waitcnt vmcnt(0)" ::: "memory");
            const unsigned og = xb_add(&bar[XB_TOP], 1u);
            const unsigned tg = og / nx;
            if (og + 1u == (tg + 1u) * nx) xb_add(&bar[XB_TOPGEN], 1u);
            else XB_SPIN(xb_ld(&bar[XB_TOPGEN]) == tg, bar);
            __builtin_amdgcn_fence(__ATOMIC_ACQUIRE, "agent");
            xb_add(&bar[XB_XGEN(b.x)], 1u);
            asm volatile("s_waitcnt vmcnt(0)" ::: "memory");
        } else {
            XB_SPIN(xb_ld(&bar[XB_XGEN(b.x)]) == gen, bar);
            __builtin_amdgcn_fence(__ATOMIC_ACQUIRE, "agent");
            asm volatile("s_waitcnt vmcnt(0)" ::: "memory");
        }
    }
    __syncthreads();
}

struct Args { const float* in[26]; float* out; unsigned char* ws; };
enum { I_XP = 0, I_XS, I_SRGC, I_SRGH, I_CK, I_CV, I_SFFN, I_RGNORM, I_RGWIN, I_RGCW, I_RGCB, I_RGGW, I_RGGB, I_RGLL, I_RGWOUT, I_ATNORM, I_ATWQKV, I_ATLAM, I_ATSUBLN, I_ATWOUT,
       I_FFNNORM, I_FFNWUP, I_FFNCW, I_FFNCB, I_FFNWDN, I_FINNORM };

__device__ __forceinline__ void p0_transpose_item(const float* W, const float* gain, int K, int N, bf16* WT, int mode, LAS float* scr, int item, int lane) {
    const int nblk = N / 64, kb = item / nblk, nb = item % nblk, k0 = 64 * kb, n0 = 64 * nb;
    const int c = lane & 7;
    f32x4 g0 = {1.f, 1.f, 1.f, 1.f}, g1 = g0;
    if (gain) { g0 = *(const f32x4*)(gain + k0 + 8 * c); g1 = *(const f32x4*)(gain + k0 + 8 * c + 4); }
    float w[64];
    const float* wp = W + (size_t)k0 * N + n0 + lane;
#pragma unroll
    for (int i = 0; i < 64; ++i) w[i] = wp[(size_t)i * N];
#pragma unroll
    for (int i = 0; i < 64; ++i) scr[i * 65 + lane] = w[i];
    LDS_WAIT(); asm volatile("" ::: "memory");
    int r0 = n0;
    if (mode == 1) { const int j = n0 < DFF ? n0 : n0 - DFF; r0 = 256 * (j >> 7) + (n0 < DFF ? 0 : 128) + (j & 127); }
#pragma unroll
    for (int j = 0; j < 8; ++j) { const int n = (lane >> 3) + 8 * j; const LAS float* s = scr + (8 * c) * 65 + n;
        v4u o; o.x = cvtpk(s[0 * 65] * g0[0], s[1 * 65] * g0[1]); o.y = cvtpk(s[2 * 65] * g0[2], s[3 * 65] * g0[3]); o.z = cvtpk(s[4 * 65] * g1[0], s[5 * 65] * g1[1]); o.w = cvtpk(s[6 * 65] * g1[2], s[7 * 65] * g1[3]);
        *(GAS v4u*)(WT + (size_t)(r0 + n) * K + k0 + 8 * c) = o; }
    LDS_WAIT(); asm volatile("" ::: "memory");
}

__device__ __forceinline__ float rstd_from_ss(const float* ss, int row, int fq) {
    const f32x4* p = (const f32x4*)(ss + (size_t)row * 32 + 8 * fq);
    const f32x4 a = p[0], b = p[1];
    float s = ((a[0] + a[1]) + (a[2] + a[3])) + ((b[0] + b[1]) + (b[2] + b[3]));
    s += __shfl_xor(s, 16); s += __shfl_xor(s, 32);
    return __builtin_amdgcn_rsqf(s * (1.0f / DM) + EPS);
}

__device__ __forceinline__ GAS char* uni_f(const void* p) { const unsigned long long b = (unsigned long long)p; const unsigned lo = __builtin_amdgcn_readfirstlane((unsigned)b), hi = __builtin_amdgcn_readfirstlane((unsigned)(b >> 32)); return (GAS char*)(((unsigned long long)hi << 32) | lo); }
typedef f32x4 AccT[2][2][4][2];
struct EpiWin {
    static constexpr bool PERM = true, PRE = true; static constexpr int NST = 16;
    bf16* U; const float* rs;
    __device__ __forceinline__ void prefetch(LAS unsigned char* ep, const pg8::Unit& u, int wid, int lane) const {
        if (wid < 4) __builtin_amdgcn_global_load_lds((const unsigned*)(rs + u.pm * 256 + wid * 64 + lane), (LAS unsigned*)(ep + 4096 + wid * 256), 4, 0, 0);
    }
    static constexpr bool FUSED_PART = true;
    __device__ __forceinline__ void operator()(AccT& acc, const pg8::Unit& u, int wr, int wc, int fr_in, int fq_in, LAS unsigned char* ep) const { run<false>(acc, u, wr, wc, fr_in, fq_in, ep, nullptr); }
    template <bool PART>
    __device__ __forceinline__ void run(AccT& acc, const pg8::Unit& u, int wr, int wc, int fr_in, int fq_in, LAS unsigned char* ep, const GAS char* part) const {
        int fr = fr_in, fq = fq_in; asm volatile("" : "+v"(fr), "+v"(fq));
        const int row0 = u.pm * 256 + wr * 64 + fr, col0 = u.pn * 256 + wc * 32 + 8 * fq; const bool act = u.pn < 8;
        const LAS char* rsb = (const LAS char*)ep + 4096 + (wr * 64 + fr) * 4;
        float r[2][4];
#pragma unroll
        for (int ai = 0; ai < 2; ++ai)
#pragma unroll
            for (int m = 0; m < 4; ++m) r[ai][m] = *(const LAS float*)(rsb + (ai * 128 + m * 16) * 4);
        f32x4 pb[2][2][2];
#define PART_LD(slot, g) do { _Pragma("unroll") for (int bj_ = 0; bj_ < 2; ++bj_) _Pragma("unroll") for (int n_ = 0; n_ < 2; ++n_) \
            pb[slot][bj_][n_] = *(const GAS f32x4*)(part + (((((g) >> 2) * 2 + bj_) * 4 + ((g) & 3)) * 2 + n_) * 8192); } while (0)
        if constexpr (PART) { PART_LD(0, 0); PART_LD(1, 1); }
#pragma unroll
        for (int g = 0; g < 8; ++g) { const int ai = g >> 2, m = g & 3; const int row = row0 + ai * 128 + m * 16; const float rs_ = r[ai][m];
            f32x4 a[2][2];
#pragma unroll
            for (int bj = 0; bj < 2; ++bj)
#pragma unroll
                for (int n = 0; n < 2; ++n) { a[bj][n] = acc[ai][bj][m][n]; if constexpr (PART) a[bj][n] += pb[g & 1][bj][n]; }
            if constexpr (PART) { if (g + 2 < 8) PART_LD(g & 1, g + 2); asm volatile("" ::: "memory"); }
#pragma unroll
            for (int bj = 0; bj < 2; ++bj) { f32x4 v0 = a[bj][0] * rs_, v1 = a[bj][1] * rs_;
                if (act) { v0 = gelu4(v0); v1 = gelu4(v1); }
                v4u w; w.x = cvtpk(v0[0], v0[1]); w.y = cvtpk(v0[2], v0[3]); w.z = cvtpk(v1[0], v1[1]); w.w = cvtpk(v1[2], v1[3]);
                *(v4u*)(U + (size_t)row * 4096 + col0 + bj * 128) = w; } }
#undef PART_LD
    }
};
struct EpiResid {
    static constexpr bool PERM = true, PRE = false; static constexpr int NST = 48;
    const float* baseP; const float* baseS; float* X; bf16* XB; float* ssout;
    __device__ __forceinline__ void operator()(AccT& acc, const pg8::Unit& u, int wr, int wc, int fr_in, int fq_in, LAS unsigned char*) const {
        int fr = fr_in, fq = fq_in; asm volatile("" : "+v"(fr), "+v"(fq));
        const int row0 = u.pm * 256 + wr * 64 + fr, col0 = u.pn * 256 + wc * 32 + 8 * fq;
        const float* bp0 = (u.pm < 128) ? baseP + (size_t)row0 * DM + col0 : baseS + (size_t)(row0 - MP) * DM + col0;
        f32x4 b[4][2][2];
#define RESID_LD(slot, g) { const float* q_ = bp0 + (size_t)(((g) >> 2) * 128 + ((g) & 3) * 16) * DM; \
            b[slot][0][0] = *(const f32x4*)(q_); b[slot][0][1] = *(const f32x4*)(q_ + 4); b[slot][1][0] = *(const f32x4*)(q_ + 128); b[slot][1][1] = *(const f32x4*)(q_ + 132); }
        RESID_LD(0, 0); RESID_LD(1, 1); RESID_LD(2, 2); RESID_LD(3, 3);
#pragma unroll
        for (int g = 0; g < 8; ++g) { const int ai = g >> 2, m = g & 3, row = row0 + ai * 128 + m * 16; float q = 0.f;
            f32x4 o[2][2];
#pragma unroll
            for (int bj = 0; bj < 2; ++bj) { o[bj][0] = b[g & 3][bj][0] + acc[ai][bj][m][0]; o[bj][1] = b[g & 3][bj][1] + acc[ai][bj][m][1]; }
            if (g + 4 < 8) RESID_LD(g & 3, g + 4);
            asm volatile("" ::: "memory");
#pragma unroll
            for (int bj = 0; bj < 2; ++bj) { const int col = col0 + bj * 128; const f32x4 o0 = o[bj][0], o1 = o[bj][1];
                *(f32x4*)(X + (size_t)row * DM + col) = o0; *(f32x4*)(X + (size_t)row * DM + col + 4) = o1;
                v4u w; w.x = cvtpk(o0[0], o0[1]); w.y = cvtpk(o0[2], o0[3]); w.z = cvtpk(o1[0], o1[1]); w.w = cvtpk(o1[2], o1[3]);
                *(v4u*)(XB + (size_t)row * DM + col) = w;
                q += (o0[0] * o0[0] + o0[1] * o0[1]) + (o0[2] * o0[2] + o0[3] * o0[3]) + (o1[0] * o1[0] + o1[1] * o1[1]) + (o1[2] * o1[2] + o1[3] * o1[3]); }
            q += __shfl_xor(q, 16); q += __shfl_xor(q, 32);
            if (fq == 0) ssout[(size_t)row * 32 + 4 * u.pn + wc] = q; }
#undef RESID_LD
    }
};
struct EpiSlab {
    static constexpr bool PERM = true, PRE = false; static constexpr int NST = 32;
    float* slab; int kc;
    __device__ __forceinline__ void operator()(AccT& acc, const pg8::Unit& u, int wr, int wc, int fr_in, int fq_in, LAS unsigned char*) const {
        int fr = fr_in, fq = fq_in; asm volatile("" : "+v"(fr), "+v"(fq));
        const int ks = u.ko / kc;
        GAS char* base = uni_f(slab + ((size_t)ks * MS + (size_t)(u.pm - 128) * 256 + wr * 64) * DM + u.pn * 256 + wc * 32);
        const unsigned lo = (unsigned)(fr * DM + 8 * fq) * 4u;
#pragma unroll
        for (int ai = 0; ai < 2; ++ai)
#pragma unroll
            for (int m = 0; m < 4; ++m)
#pragma unroll
                for (int bj = 0; bj < 2; ++bj) { GAS char* p = base + lo + (unsigned)((ai * 128 + m * 16) * DM + bj * 128) * 4u;
                    *(GAS f32x4*)p = acc[ai][bj][m][0]; *(GAS f32x4*)(p + 16) = acc[ai][bj][m][1]; }
    }
};
struct EpiQkv {
    static constexpr bool PERM = true, PRE = true; static constexpr int NST = 16;
    bf16* Qb; bf16* Kb; bf16* Vb; float* out; const float* rs;
    __device__ __forceinline__ void prefetch(LAS unsigned char* ep, const pg8::Unit& u, int wid, int lane) const {
        if (wid < 4) __builtin_amdgcn_global_load_lds((const unsigned*)(rs + u.pm * 256 + wid * 64 + lane), (LAS unsigned*)(ep + 4096 + wid * 256), 4, 0, 0);
    }
    static constexpr bool FUSED_PART = true;
    __device__ __forceinline__ void operator()(AccT& acc, const pg8::Unit& u, int wr, int wc, int fr_in, int fq_in, LAS unsigned char* ep) const { run<false>(acc, u, wr, wc, fr_in, fq_in, ep, nullptr); }
    template <bool PART>
    __device__ __forceinline__ void run(AccT& acc, const pg8::Unit& u, int wr, int wc, int fr_in, int fq_in, LAS unsigned char* ep, const GAS char* part) const {
        int fr = fr_in, fq = fq_in; asm volatile("" : "+v"(fr), "+v"(fq));
        const int t = u.pn >> 3; const int rl0 = wr * 64 + fr, col0 = (u.pn & 7) * 256 + wc * 32 + 8 * fq;
        bf16* dst = Qb + (size_t)t * ((WS_K - WS_Q) / 2) + (size_t)u.pm * 256 * DM;
        const size_t tk = (size_t)(t == 2 ? 1 : 0);
        float* fo = (u.pm < 128) ? out + O_K_P + tk * ((size_t)MP * DM) + (size_t)u.pm * 256 * DM : out + O_K_S + tk * ((size_t)MS * DM) + (size_t)(u.pm - 128) * 256 * DM;
        const LAS char* rsb = (const LAS char*)ep + 4096 + (wr * 64 + fr) * 4;
        float r[2][4];
#pragma unroll
        for (int ai = 0; ai < 2; ++ai)
#pragma unroll
            for (int m = 0; m < 4; ++m) r[ai][m] = *(const LAS float*)(rsb + (ai * 128 + m * 16) * 4);
        f32x4 pb[2][2][2];
#define PART_LD(slot, g) do { _Pragma("unroll") for (int bj_ = 0; bj_ < 2; ++bj_) _Pragma("unroll") for (int n_ = 0; n_ < 2; ++n_) \
            pb[slot][bj_][n_] = *(const GAS f32x4*)(part + (((((g) >> 2) * 2 + bj_) * 4 + ((g) & 3)) * 2 + n_) * 8192); } while (0)
        if constexpr (PART) { PART_LD(0, 0); PART_LD(1, 1); }
#pragma unroll
        for (int g = 0; g < 8; ++g) { const int ai = g >> 2, m = g & 3; const int rl = rl0 + ai * 128 + m * 16; const float rs_ = r[ai][m];
            f32x4 a[2][2];
#pragma unroll
            for (int bj = 0; bj < 2; ++bj)
#pragma unroll
                for (int n = 0; n < 2; ++n) { a[bj][n] = acc[ai][bj][m][n]; if constexpr (PART) a[bj][n] += pb[g & 1][bj][n]; }
            if constexpr (PART) { if (g + 2 < 8) PART_LD(g & 1, g + 2); asm volatile("" ::: "memory"); }
#pragma unroll
            for (int bj = 0; bj < 2; ++bj) { const int col = col0 + bj * 128; const f32x4 v0 = a[bj][0] * rs_, v1 = a[bj][1] * rs_;
                v4u w; w.x = cvtpk(v0[0], v0[1]); w.y = cvtpk(v0[2], v0[3]); w.z = cvtpk(v1[0], v1[1]); w.w = cvtpk(v1[2], v1[3]);
                *(v4u*)(dst + (size_t)rl * DM + col) = w;
                if (t > 0) { *(f32x4*)(fo + (size_t)rl * DM + col) = v0; *(f32x4*)(fo + (size_t)rl * DM + col + 4) = v1; } }
            asm volatile("" ::: "memory"); }
#undef PART_LD
    }
};
struct EpiFfnUp {
    static constexpr bool PERM = true, PRE = true, FUSED_PART = false; static constexpr int NST = 32;
    bf16* H; float* UE; const float* rs; const float* cw; const float* cb;
    __device__ __forceinline__ void prefetch(LAS unsigned char* ep, const pg8::Unit& u, int wid, int lane) const {
        const int k = wid >> 1, half = wid & 1;
        const float* src = (k < 3 ? cw + (size_t)k * NUP : cb) + (half ? DFF : 0) + 128 * u.pn + lane;
        __builtin_amdgcn_global_load_lds((const unsigned*)src, (LAS unsigned*)(ep + (k * 256 + half * 128) * 4), 4, 0, 0);
        __builtin_amdgcn_global_load_lds((const unsigned*)(src + 64), (LAS unsigned*)(ep + (k * 256 + half * 128 + 64) * 4), 4, 0, 0);
        if (wid < 4) __builtin_amdgcn_global_load_lds((const unsigned*)(rs + u.pm * 256 + wid * 64 + lane), (LAS unsigned*)(ep + 4096 + wid * 256), 4, 0, 0);
    }
    __device__ __forceinline__ void operator()(AccT& acc, const pg8::Unit& u, int wr, int wc, int fr_in, int fq_in, LAS unsigned char* ep) const {
        int fr = fr_in, fq = fq_in; asm volatile("" : "+v"(fr), "+v"(fq));
        const bool samp = u.pm >= 128; const int colg0 = 128 * u.pn + 32 * wc;
        const LAS char* rsb = (const LAS char*)ep + 4096 + (wr * 64 + fr) * 4;
        float r[2][4];
#pragma unroll
        for (int ai = 0; ai < 2; ++ai)
#pragma unroll
            for (int m = 0; m < 4; ++m) r[ai][m] = *(const LAS float*)(rsb + (ai * 128 + m * 16) * 4);
        const LAS char* cwl = (const LAS char*)ep + (32 * wc + 8 * fq) * 4;
#pragma unroll
        for (int ai = 0; ai < 2; ++ai)
#pragma unroll
            for (int m = 0; m < 4; ++m)
#pragma unroll
                for (int bj = 0; bj < 2; ++bj) { acc[ai][bj][m][0] *= r[ai][m]; acc[ai][bj][m][1] *= r[ai][m]; }
#pragma unroll
        for (int ai = 0; ai < 2; ++ai)
#pragma unroll
            for (int bj = 0; bj < 2; ++bj)
                asm volatile("s_nop 1" : "+v"(acc[ai][bj][0][0]), "+v"(acc[ai][bj][0][1]), "+v"(acc[ai][bj][1][0]), "+v"(acc[ai][bj][1][1]), "+v"(acc[ai][bj][2][0]), "+v"(acc[ai][bj][2][1]), "+v"(acc[ai][bj][3][0]), "+v"(acc[ai][bj][3][1]));
        {
            const unsigned cl = (unsigned)(8 * fq) * 4u;
#pragma unroll
            for (int ai = 0; ai < 2; ++ai)
#pragma unroll
                for (int m = 0; m < 4; ++m) {
                    const bool first = (fr < 2) && (m == 0 || (samp && m == 2)), lastr = (fr >= 14) && (m == 3 || (samp && m == 1));
                    if (first || lastr) { const int slot = first ? fr : fr - 12;
                        const int cbi = samp ? 512 + (u.pm - 128) * 8 + ai * 4 + wr * 2 + (m >> 1) : u.pm * 4 + ai * 2 + wr;
                        GAS char* p = (GAS char*)uni_f(UE + (size_t)cbi * 4 * NUP + colg0) + (unsigned)slot * (NUP * 4u) + cl;
#pragma unroll
                        for (int bj = 0; bj < 2; ++bj) { *(GAS f32x4*)(p + bj * DFF * 4) = acc[ai][bj][m][0]; *(GAS f32x4*)(p + bj * DFF * 4 + 16) = acc[ai][bj][m][1]; } } } }
        GAS char* Hb = (GAS char*)uni_f(H + (size_t)(u.pm * 256 + wr * 64) * DFF + colg0);
        const unsigned hl = (unsigned)(fr * DFF + 8 * fq) * 2u;
#pragma unroll
        for (int n = 0; n < 2; ++n) {
            f32x4 w0[2], w1[2], w2[2], bb[2];
#pragma unroll
            for (int bj = 0; bj < 2; ++bj) { const int c = (bj * 128 + 4 * n) * 4; w0[bj] = *(const LAS f32x4*)(cwl + c); w1[bj] = *(const LAS f32x4*)(cwl + 1024 + c); w2[bj] = *(const LAS f32x4*)(cwl + 2048 + c); bb[bj] = *(const LAS f32x4*)(cwl + 3072 + c); }
#pragma unroll
            for (int ai = 0; ai < 2; ++ai)
#pragma unroll
                for (int m = 0; m < 4; ++m) { f32x4 cv[2];
#pragma unroll
                    for (int bj = 0; bj < 2; ++bj) { cv[bj] = bb[bj] + w2[bj] * acc[ai][bj][m][n];
#pragma unroll
                        for (int i = 0; i < 4; ++i) { float c = cv[bj][i]; const float cur = acc[ai][bj][m][n][i];
                            FMAC_DPP(c, cur, w1[bj][i], "row_shr:1"); FMAC_DPP(c, cur, w0[bj][i], "row_shr:2");
                            if (m > 0) { const float pv = acc[ai][bj][m - 1][n][i]; FMAC_DPP(c, pv, w1[bj][i], "row_shl:15"); FMAC_DPP(c, pv, w0[bj][i], "row_shl:14"); }
                            cv[bj][i] = c; } }
                    v2u w; { const f32x4 h = gelu4_mul(cv[0], cv[1]); w.x = cvtpk(h[0], h[1]); w.y = cvtpk(h[2], h[3]); }
                    *(GAS v2u*)(Hb + hl + (unsigned)((ai * 128 + m * 16) * DFF + 4 * n) * 2u) = w;
                    __builtin_amdgcn_sched_barrier(0); } }
    }
};

template <class Epi, int f> struct EpiTail {
    static constexpr bool PERM = Epi::PERM, PRE = Epi::PRE; static constexpr int NST = 16;
    Epi E; float* slab; unsigned* flag; int kc, nN;
    __device__ __forceinline__ void prefetch(LAS unsigned char* ep, const pg8::Unit& u, int wid, int lane) const { if constexpr (Epi::PRE) E.prefetch(ep, u, wid, lane); }
    __device__ __forceinline__ void operator()(AccT& acc, const pg8::Unit& u, int wr, int wc, int fr, int fq, LAS unsigned char* ep) const {
        int tid = threadIdx.x; asm volatile("" : "+v"(tid));
        const int ks = u.ko / kc, tile = (u.pm - 128) * nN + u.pn;
        float* tslab = slab + (size_t)tile * (size_t)(f - 1) * (32 * 512 * 4);
        unsigned* tflag = flag + tile;
        if (ks < f - 1) {
            GAS char* p = (GAS char*)uni_f(tslab + (size_t)ks * (32 * 512 * 4)); const unsigned vo = (unsigned)tid * 16u;
#pragma unroll
            for (int ai = 0; ai < 2; ++ai)
#pragma unroll
                for (int bj = 0; bj < 2; ++bj)
#pragma unroll
                    for (int m = 0; m < 4; ++m)
#pragma unroll
                        for (int n = 0; n < 2; ++n) { GAS char* q = p + (((ai * 2 + bj) * 4 + m) * 2 + n) * 8192;
                            asm volatile("global_store_dwordx4 %0, %1, %2 sc1" :: "v"(vo), "v"(acc[ai][bj][m][n]), "s"(q) : "memory"); }
            asm volatile("s_waitcnt vmcnt(0)" ::: "memory");
            if ((tid & 63) == 0) (void)__hip_atomic_fetch_add(tflag, 1u, __ATOMIC_RELAXED, __HIP_MEMORY_SCOPE_AGENT);
        } else {
            const unsigned want = (unsigned)(f - 1) * 8u; unsigned sp = 0;
            while ((unsigned)__builtin_amdgcn_readfirstlane(__hip_atomic_load(tflag, __ATOMIC_RELAXED, __HIP_MEMORY_SCOPE_AGENT)) < want) { __builtin_amdgcn_s_sleep(1); if (++sp > (1u << 22)) break; }
            __builtin_amdgcn_fence(__ATOMIC_ACQUIRE, "agent");
            if constexpr (Epi::FUSED_PART) { static_assert(f == 2, "fused partial: one writer");
                E.template run<true>(acc, u, wr, wc, fr, fq, ep, (const GAS char*)uni_f(tslab) + (unsigned)tid * 16u); return; }
#pragma unroll
            for (int s = 0; s < f - 1; ++s) {
                const GAS char* p = (const GAS char*)uni_f(tslab + (size_t)s * (32 * 512 * 4)); const unsigned vo = (unsigned)tid * 16u;
#pragma unroll
                for (int ai = 0; ai < 2; ++ai)
#pragma unroll
                    for (int bj = 0; bj < 2; ++bj)
#pragma unroll
                        for (int m = 0; m < 4; ++m) { f32x4 t[2];
#pragma unroll
                            for (int n = 0; n < 2; ++n) t[n] = *(const GAS f32x4*)(p + (((ai * 2 + bj) * 4 + m) * 2 + n) * 8192 + vo);
#pragma unroll
                            for (int n = 0; n < 2; ++n)
#pragma unroll
                                for (int i = 0; i < 4; ++i) { float a = acc[ai][bj][m][n][i]; asm volatile("v_add_f32 %0, %0, %1" : "+v"(a) : "v"(t[n][i])); acc[ai][bj][m][n][i] = a; }
                            __builtin_amdgcn_sched_barrier(0); }
            }
            E(acc, u, wr, wc, fr, fq, ep);
        }
    }
};

struct Ctx {
    LAS unsigned char* lds; unsigned char* ws; float* out; int vcu, G;
};
__device__ __forceinline__ void p0_prologue(const Ctx& F, const Args& a) {
    const int tid = opaque_tid(), lane = tid & 63, wave = __builtin_amdgcn_readfirstlane(tid >> 6);
    LAS float* scr = (LAS float*)(F.lds + RING_OFF + wave * 16640);
    const int gw = F.vcu * NWAVES + wave, NGW = F.G * NWAVES;
    constexpr int I_WIN = (DM / 64) * (4096 / 64), I_RGO = (DM / 64) * (DM / 64), I_QKV = (DM / 64) * (NQKV / 64), I_ATO = I_RGO, I_UP = (DM / 64) * (NUP / 64), I_DN = (DFF / 64) * (DM / 64), I_GW = 2 * 4;
    static_assert(8 * 16640 <= LDSCTL_OFF, "prologue scratch");
    static_assert(RING_BYTES + 2 * 5120 <= LDSCTL_OFF, "epilogue tables behind the GEMM ring");
    constexpr int NITEMS = I_WIN + I_RGO + I_QKV + I_ATO + 2 * I_UP + 2 * I_DN + 16 * I_GW;
    for (int it = gw; it < NITEMS; it += NGW) {
        int r = it;
        if (r < I_WIN) { p0_transpose_item(a.in[I_RGWIN], a.in[I_RGNORM], DM, 4096, (bf16*)(F.ws + WS_WIN), 0, scr, r, lane); continue; } r -= I_WIN;
        if (r < I_RGO) { p0_transpose_item(a.in[I_RGWOUT], nullptr, DM, DM, (bf16*)(F.ws + WS_RGO), 0, scr, r, lane); continue; } r -= I_RGO;
        if (r < I_QKV) { p0_transpose_item(a.in[I_ATWQKV], a.in[I_ATNORM], DM, NQKV, (bf16*)(F.ws + WS_QKV), 0, scr, r, lane); continue; } r -= I_QKV;
        if (r < I_ATO) { p0_transpose_item(a.in[I_ATWOUT], nullptr, DM, DM, (bf16*)(F.ws + WS_ATO), 0, scr, r, lane); continue; } r -= I_ATO;
        if (r < I_UP) { p0_transpose_item(a.in[I_FFNWUP], a.in[I_FFNNORM], DM, NUP, (bf16*)(F.ws + WS_UP0), 1, scr, r, lane); continue; } r -= I_UP;
        if (r < I_UP) { p0_transpose_item(a.in[I_FFNWUP] + (size_t)DM * NUP, a.in[I_FFNNORM] + DM, DM, NUP, (bf16*)(F.ws + WS_UP1), 1, scr, r, lane); continue; } r -= I_UP;
        if (r < I_DN) { p0_transpose_item(a.in[I_FFNWDN], nullptr, DFF, DM, (bf16*)(F.ws + WS_DN0), 0, scr, r, lane); continue; } r -= I_DN;
        if (r < I_DN) { p0_transpose_item(a.in[I_FFNWDN] + (size_t)DFF * DM, nullptr, DFF, DM, (bf16*)(F.ws + WS_DN1), 0, scr, r, lane); continue; } r -= I_DN;
        { const int n = r / I_GW, rr = r % I_GW;
          p0_transpose_item(a.in[I_RGGW] + (size_t)n * 128 * 256, nullptr, 128, 256, (bf16*)(F.ws + WS_GW) + (size_t)n * 256 * 128, 0, scr, rr, lane); }
    }
    bf16* XB = (bf16*)(F.ws + WS_XB); float* rs0 = (float*)(F.ws + WS_SS) + RS_OFF;
    f32x4 v[8];
#pragma unroll
    for (int j = 0; j < 8; ++j) v[j] = (f32x4){0.f, 0.f, 0.f, 0.f};
    int m = gw;
    if (m < MT) { const GAS f32x4* xv = (const GAS f32x4*)((m < MP) ? a.in[I_XP] + (size_t)m * DM : a.in[I_XS] + (size_t)(m - MP) * DM) + lane;
#pragma unroll
        for (int j = 0; j < 8; ++j) v[j] = xv[64 * j]; }
    while (m < MT) {
        const int mn = m + NGW; f32x4 vn[8];
#pragma unroll
        for (int j = 0; j < 8; ++j) vn[j] = (f32x4){0.f, 0.f, 0.f, 0.f};
        if (mn < MT) { const GAS f32x4* xn = (const GAS f32x4*)((mn < MP) ? a.in[I_XP] + (size_t)mn * DM : a.in[I_XS] + (size_t)(mn - MP) * DM) + lane;
#pragma unroll
            for (int j = 0; j < 8; ++j) vn[j] = xn[64 * j]; }
        asm volatile("" ::: "memory");
        float s = 0.f;
#pragma unroll
        for (int j = 0; j < 8; ++j) s += (v[j][0] * v[j][0] + v[j][1] * v[j][1]) + (v[j][2] * v[j][2] + v[j][3] * v[j][3]);
        s = wave_sum(s);
        GAS v2u* o8 = (GAS v2u*)(XB + (size_t)m * DM) + lane;
#pragma unroll
        for (int j = 0; j < 8; ++j) { v2u w; w.x = cvtpk(v[j][0], v[j][1]); w.y = cvtpk(v[j][2], v[j][3]); o8[64 * j] = w; }
        if (lane == 0) rs0[m] = __builtin_amdgcn_rsqf(s * (1.0f / DM) + EPS);
#pragma unroll
        for (int j = 0; j < 8; ++j) v[j] = vn[j];
        m = mn;
    }
}

constexpr int RG_REC = 0, RG_Y = 35840, RG_XCF = 53248, RG_XCB = 87040, RG_HY = 104448;
static_assert(RG_HY + 64 * 136 * 2 <= RING_BYTES, "rglru LDS map");
__device__ __forceinline__ void rglru_phase(const Ctx& F, const Args& a) {
    const int tid = opaque_tid(), lane = tid & 63, wid = __builtin_amdgcn_readfirstlane(tid >> 6), col = lane & 15, quad = lane >> 4;
    LAS float* recf = (LAS float*)(F.lds + RG_REC); LAS unsigned short* ytile = (LAS unsigned short*)(F.lds + RG_Y);
    LAS float* xcf = (LAS float*)(F.lds + RG_XCF); LAS unsigned short* xcb = (LAS unsigned short*)(F.lds + RG_XCB); LAS unsigned short* hyt = (LAS unsigned short*)(F.lds + RG_HY);
    const bf16* U = (const bf16*)(F.ws + WS_U); bf16* HY = (bf16*)(F.ws + WS_HY); const bf16* GWt = (const bf16*)(F.ws + WS_GW);
    for (int unit = blockIdx.x; unit < 512; unit += F.G) {
        const bool samp = unit >= 256; const int uu = samp ? unit - 256 : unit, b = uu >> 4, n = uu & 15;
        const int T = samp ? DECS : SEQ, row0 = samp ? MP + DECS * b : SEQ * b;
        bf16x8 Br[4], Bi[4];
        { const bf16* gw = GWt + (size_t)n * 256 * 128;
#pragma unroll
          for (int ks = 0; ks < 4; ++ks) { Br[ks] = *(const bf16x8*)(gw + (size_t)(16 * wid + col) * 128 + 32 * ks + 8 * quad); Bi[ks] = *(const bf16x8*)(gw + (size_t)(128 + 16 * wid + col) * 128 + 32 * ks + 8 * quad); } }
        const int ch = 128 * n + 16 * wid + col;
        const float gbr = a.in[I_RGGB][n * 256 + 16 * wid + col], gbi = a.in[I_RGGB][n * 256 + 128 + 16 * wid + col];
        const float sp8 = 8.f * log1pf(__expf(-a.in[I_RGLL][ch]));
        float hcar = samp ? a.in[I_SRGH][b * 2048 + ch] : 0.f;
        const int cc = tid & 127, rg4 = tid >> 7, cch = 128 * n + cc;
        const float cw0 = a.in[I_RGCW][cch], cw1 = a.in[I_RGCW][2048 + cch], cw2 = a.in[I_RGCW][4096 + cch], cw3 = a.in[I_RGCW][6144 + cch], cbias = a.in[I_RGCB][cch];
        float* o_rgc = F.out + (samp ? O_RGC_S : O_RGC_P); float* o_rgh = F.out + (samp ? O_RGH_S : O_RGH_P);
        const int r = tid >> 4, c8 = (tid & 15) * 8;
        const bf16* Urec = U + (size_t)row0 * 4096 + 2048 + 128 * n + c8; const bf16* Uy = U + (size_t)row0 * 4096 + 128 * n + c8;
        v4u rraw[3], yraw[2];
#define RG_LOAD(t0_) do { _Pragma("unroll") for (int p = 0; p < 3; ++p) { const int rr = 32 * p + r, t = (t0_) - 3 + rr; rraw[p] = (v4u){0u, 0u, 0u, 0u}; if (rr < 67 && t >= 0 && t < T) rraw[p] = *(const v4u*)(Urec + (size_t)t * 4096); } \
        _Pragma("unroll") for (int p = 0; p < 2; ++p) { const int t = (t0_) + 32 * p + r; yraw[p] = (v4u){0u, 0u, 0u, 0u}; if (t < T) yraw[p] = *(const v4u*)(Uy + (size_t)t * 4096); } } while (0)
        RG_LOAD(0);
        for (int t0 = 0; t0 < T; t0 += 64) {
#pragma unroll
            for (int p = 0; p < 3; ++p) { const int rr = 32 * p + r; if (rr < 67) { const int t = t0 - 3 + rr; const v4u w = rraw[p];
                    f32x4 lo = (f32x4){__builtin_bit_cast(float, w.x << 16), __builtin_bit_cast(float, w.x & 0xffff0000u), __builtin_bit_cast(float, w.y << 16), __builtin_bit_cast(float, w.y & 0xffff0000u)};
                    f32x4 hi = (f32x4){__builtin_bit_cast(float, w.z << 16), __builtin_bit_cast(float, w.z & 0xffff0000u), __builtin_bit_cast(float, w.w << 16), __builtin_bit_cast(float, w.w & 0xffff0000u)};
                    if (t < 0 && samp) { const float* sp = a.in[I_SRGC] + (size_t)(b * 3 + 3 + t) * 2048 + 128 * n + c8; lo = *(const f32x4*)sp; hi = *(const f32x4*)(sp + 4); }
                    *(LAS f32x4*)(recf + rr * 132 + c8) = lo; *(LAS f32x4*)(recf + rr * 132 + c8 + 4) = hi; } }
#pragma unroll
            for (int p = 0; p < 2; ++p) *(LAS v4u*)(ytile + (32 * p + r) * 136 + c8) = yraw[p];
            LDS_WAIT(); __syncthreads();
            if (t0 + 64 < T) RG_LOAD(t0 + 64);
            { float x[19];
#pragma unroll
              for (int k = 0; k < 19; ++k) x[k] = recf[(16 * rg4 + k) * 132 + cc];
#pragma unroll
              for (int i = 0; i < 16; ++i) { const float xc = cbias + cw0 * x[i] + cw1 * x[i + 1] + cw2 * x[i + 2] + cw3 * x[i + 3];
                    xcf[(16 * rg4 + i) * 132 + cc] = xc; xcb[(16 * rg4 + i) * 136 + cc] = (unsigned short)(cvtpk(xc, 0.f) & 0xffffu); }
              if (t0 + 64 >= T && tid < 384) { const int k = tid >> 7; o_rgc[(size_t)(b * 3 + k) * 2048 + cch] = recf[(T - t0 + k) * 132 + cc]; } }
            LDS_WAIT(); __syncthreads();
#pragma unroll
            for (int rb = 0; rb < 4; ++rb) {
                if (t0 + 16 * rb < T) {
                    f32x4 accR = {0.f, 0.f, 0.f, 0.f}, accI = accR;
#pragma unroll
                    for (int ks = 0; ks < 4; ++ks) { const bf16x8 af = *(const LAS bf16x8*)(xcb + (16 * rb + col) * 136 + 32 * ks + 8 * quad);
                        accR = __builtin_amdgcn_mfma_f32_16x16x32_bf16(af, Br[ks], accR, 0, 0, 0); accI = __builtin_amdgcn_mfma_f32_16x16x32_bf16(af, Bi[ks], accI, 0, 0, 0); }
                    float av[4], bv[4]; float As = 1.f, Bs = 0.f;
#pragma unroll
                    for (int j = 0; j < 4; ++j) { const int t = 16 * rb + 4 * quad + j; const float xc = xcf[t * 132 + 16 * wid + col];
                        const float rg = sigmoidf_(accR[j] + gbr), ig = sigmoidf_(accI[j] + gbi), la = -sp8 * rg, aa = __builtin_amdgcn_exp2f(la * 1.4426950409f), x2 = 2.f * la;
                        const float om = (x2 > -0.02f) ? -x2 * (1.f + x2 * (0.5f + x2 * (0.16666667f + x2 * 0.041666668f))) : 1.f - aa * aa;
                        av[j] = aa; bv[j] = __builtin_sqrtf(om) * ig * xc; Bs = aa * Bs + bv[j]; As = aa * As; }
                    const float A0 = __shfl(As, col), B0 = __shfl(Bs, col), A1 = __shfl(As, col + 16), B1 = __shfl(Bs, col + 16), A2 = __shfl(As, col + 32), B2 = __shfl(Bs, col + 32), A3 = __shfl(As, col + 48), B3 = __shfl(Bs, col + 48);
                    const float h1 = A0 * hcar + B0, h2 = A1 * h1 + B1, h3 = A2 * h2 + B2, h4 = A3 * h3 + B3;
                    float hs = quad == 0 ? hcar : (quad == 1 ? h1 : (quad == 2 ? h2 : h3)); hcar = h4;
#pragma unroll
                    for (int j = 0; j < 4; ++j) { const int t = 16 * rb + 4 * quad + j; hs = av[j] * hs + bv[j];
                        const float y = bf2f(ytile[t * 136 + 16 * wid + col]);
                        hyt[t * 136 + 16 * wid + col] = (unsigned short)(cvtpk(hs * y, 0.f) & 0xffffu); }
                    if (t0 + 16 * (rb + 1) == T && quad == 0) o_rgh[(size_t)b * 2048 + ch] = hcar;
                }
            }
            LDS_WAIT(); __syncthreads();
#pragma unroll
            for (int p = 0; p < 2; ++p) { const int rr = 32 * p + r; if (t0 + rr < T) *(v4u*)(HY + (size_t)(row0 + t0 + rr) * DM + 128 * n + c8) = *(const LAS v4u*)(hyt + rr * 136 + c8); }
        }
        LDS_WAIT(); __syncthreads();
#undef RG_LOAD
    }
}

__device__ __forceinline__ void ffn_fixup(const Ctx& F, const Args& a, int layer) {
    const float* UE = (const float*)(F.ws + WS_UE); bf16* H = (bf16*)(F.ws + WS_H);
    const float* cw = a.in[I_FFNCW] + (size_t)layer * 3 * NUP; const float* cb = a.in[I_FFNCB] + (size_t)layer * NUP;
    const int tid = opaque_tid();
    const long gt = (long)F.vcu * 512 + tid, NT_ = (long)F.G * 512;
    constexpr int FG = DFF / 4;
    for (long it = gt; it < (long)NCB * FG; it += NT_) {
        const int cbi = (int)(it / FG), j = (int)(it % FG) * 4;
        const bool samp = cbi >= 512; const int rowA = samp ? MP + (cbi - 512) * 32 : cbi * 64;
        f32x4 u0[2], u1[2], hm2[2], hm1[2];
#pragma unroll
        for (int bj = 0; bj < 2; ++bj) { const int c = j + bj * DFF;
            u0[bj] = *(const f32x4*)(UE + ((size_t)cbi * 4 + 0) * NUP + c); u1[bj] = *(const f32x4*)(UE + ((size_t)cbi * 4 + 1) * NUP + c);
            if (samp) { const float* st = a.in[I_SFFN] + ((size_t)(layer * 16 + (cbi - 512)) * 2) * NUP + c; hm2[bj] = *(const f32x4*)st; hm1[bj] = *(const f32x4*)(st + NUP); }
            else if ((cbi & 31) == 0) { hm2[bj] = (f32x4){0.f, 0.f, 0.f, 0.f}; hm1[bj] = hm2[bj]; }
            else { hm2[bj] = *(const f32x4*)(UE + ((size_t)(cbi - 1) * 4 + 2) * NUP + c); hm1[bj] = *(const f32x4*)(UE + ((size_t)(cbi - 1) * 4 + 3) * NUP + c); } }
        f32x4 c0[2], c1[2];
#pragma unroll
        for (int bj = 0; bj < 2; ++bj) { const int c = j + bj * DFF; const f32x4 w0 = *(const f32x4*)(cw + c), w1 = *(const f32x4*)(cw + NUP + c), w2 = *(const f32x4*)(cw + 2 * NUP + c), bb = *(const f32x4*)(cb + c);
            c0[bj] = bb + w0 * hm2[bj] + w1 * hm1[bj] + w2 * u0[bj]; c1[bj] = bb + w0 * hm1[bj] + w1 * u0[bj] + w2 * u1[bj]; }
        v2u o0, o1; float h0[4], h1[4];
#pragma unroll
        for (int i = 0; i < 4; ++i) { h0[i] = gelu_tanh(c0[0][i]) * c0[1][i]; h1[i] = gelu_tanh(c1[0][i]) * c1[1][i]; }
        o0.x = cvtpk(h0[0], h0[1]); o0.y = cvtpk(h0[2], h0[3]); o1.x = cvtpk(h1[0], h1[1]); o1.y = cvtpk(h1[2], h1[3]);
        *(v2u*)(H + (size_t)rowA * DFF + j) = o0; *(v2u*)(H + (size_t)(rowA + 1) * DFF + j) = o1;
    }
    constexpr int NV = NUP / 4;
    for (long it = gt; it < (long)32 * 2 * NV; it += NT_) {
        const int sq = (int)(it / (2 * NV)), r = (int)((it / NV) & 1), c = (int)(it % NV) * 4;
        const bool samp = sq >= 16; const int cbi = samp ? 512 + (sq - 16) : 32 * sq + 31;
        float* o = F.out + (samp ? O_FFN_S : O_FFN_P) + ((size_t)(layer * 16 + (samp ? sq - 16 : sq)) * 2 + r) * NUP + c;
        *(f32x4*)o = *(const f32x4*)(UE + ((size_t)cbi * 4 + 2 + r) * NUP + c);
    }
}

__device__ __forceinline__ void resid_finish(const Ctx& F, const float* baseS, int f, float* ssout) {
    const int tid = opaque_tid(), lane = tid & 63, wave = __builtin_amdgcn_readfirstlane(tid >> 6);
    const int gw = F.vcu * NWAVES + wave, NGW = F.G * NWAVES;
    const float* slab = (const float*)(F.ws + WS_SLAB); bf16* XB = (bf16*)(F.ws + WS_XB);
    for (int r = gw; r < MS; r += NGW) {
        f32x4 v[8];
#pragma unroll
        for (int j = 0; j < 8; ++j) v[j] = *((const GAS f32x4*)(baseS + (size_t)r * DM) + lane + 64 * j);
        for (int ks = 0; ks < f; ++ks) { const GAS f32x4* sp = (const GAS f32x4*)(slab + ((size_t)ks * MS + r) * DM) + lane;
#pragma unroll
            for (int j = 0; j < 8; ++j) v[j] += sp[64 * j]; }
        float q = 0.f;
        GAS f32x4* xo = (GAS f32x4*)(F.out + (size_t)(MP + r) * DM) + lane; GAS v2u* bo = (GAS v2u*)(XB + (size_t)(MP + r) * DM) + lane;
#pragma unroll
        for (int j = 0; j < 8; ++j) { xo[64 * j] = v[j]; v2u w; w.x = cvtpk(v[j][0], v[j][1]); w.y = cvtpk(v[j][2], v[j][3]); bo[64 * j] = w;
            q += (v[j][0] * v[j][0] + v[j][1] * v[j][1]) + (v[j][2] * v[j][2] + v[j][3] * v[j][3]); }
        q = wave_sum(q);
        if (lane == 0) ssout[RS_OFF + MP + r] = __builtin_amdgcn_rsqf(q * (1.0f / DM) + EPS);
    }
    for (long row = (long)(F.G - 1 - F.vcu) * 512 + tid; row < MP; row += (long)F.G * 512) {
        const GAS f32x4* p = (const GAS f32x4*)(ssout + (size_t)row * 32); f32x4 a[8];
#pragma unroll
        for (int j = 0; j < 8; ++j) a[j] = p[j];
        float sq = 0.f;
#pragma unroll
        for (int j = 0; j < 8; ++j) sq += (a[j][0] + a[j][1]) + (a[j][2] + a[j][3]);
        ssout[RS_OFF + row] = __builtin_amdgcn_rsqf(sq * (1.0f / DM) + EPS);
    }
}

__device__ __forceinline__ void final_norm(const Ctx& F, const Args& a, const float* ss) {
    const int tid = opaque_tid(), lane = tid & 63, wave = __builtin_amdgcn_readfirstlane(tid >> 6);
    const int gw = F.vcu * NWAVES + wave, NGW = F.G * NWAVES;
    const GAS f32x4* gv = (const GAS f32x4*)a.in[I_FINNORM] + lane;
    f32x4 g[8], v[8]; float rs = 0.f;
#pragma unroll
    for (int j = 0; j < 8; ++j) { g[j] = gv[64 * j]; v[j] = (f32x4){0.f, 0.f, 0.f, 0.f}; }
    int m = gw;
    if (m < MT) { rs = ss[RS_OFF + m]; const GAS f32x4* xv = (const GAS f32x4*)(F.out + (size_t)m * DM) + lane;
#pragma unroll
        for (int j = 0; j < 8; ++j) v[j] = xv[64 * j]; }
    while (m < MT) {
        const int mn = m + NGW; f32x4 vn[8]; float rsn = 0.f;
#pragma unroll
        for (int j = 0; j < 8; ++j) vn[j] = (f32x4){0.f, 0.f, 0.f, 0.f};
        if (mn < MT) { rsn = ss[RS_OFF + mn]; const GAS f32x4* xn = (const GAS f32x4*)(F.out + (size_t)mn * DM) + lane;
#pragma unroll
            for (int j = 0; j < 8; ++j) vn[j] = xn[64 * j]; }
        asm volatile("" ::: "memory");
        GAS f32x4* xo = (GAS f32x4*)(F.out + (size_t)m * DM) + lane;
#pragma unroll
        for (int j = 0; j < 8; ++j) xo[64 * j] = v[j] * rs * g[j];
#pragma unroll
        for (int j = 0; j < 8; ++j) v[j] = vn[j];
        rs = rsn; m = mn;
    }
}

namespace att {
constexpr int QBLK = 32, KVBLK = 64, QB = 256, PITCH = DM;
constexpr int SHM_V = 16384, SHM_K = 16384, A_V = 0, A_K = 32768, A_WS = 65536;
constexpr float SCALE = 0.08838834764831845f, THR = 8.f, C2 = 1.4426950408889634f * SCALE;
#define KSWZ(row, colB) ((row) * 256 + ((colB) ^ (((row) & 7) << 4)))
#define SBAR() __builtin_amdgcn_sched_barrier(0)
__device__ __forceinline__ int v_st(int k, int c) { const int kk = (k & ~0xC) | ((k & 4) << 1) | ((k & 8) >> 1); return ((kk >> 3) * 4 + (c >> 5)) * 512 + ((kk & 7) * 32 + (c & 31)) * 2; }
__device__ __forceinline__ int v_rd_base(int lane) { return ((lane & 3) << 3) | (((lane >> 2) & 3) << 6) | (((lane >> 4) & 1) << 5) | (((lane >> 5) & 1) << 8); }
constexpr int v_rd_off(int d0, int ks, int half) { return d0 * 512 + ks * 4096 + half * 2048; }
__device__ __forceinline__ int crow(int r, int hi) { return (r & 3) + 8 * (r >> 2) + 4 * hi; }
__device__ __forceinline__ void partialSM(f32x16& p0, f32x16& p1, float& m_reg, float& mn, float& alpha) {
    float pmax = p0[0];
#pragma unroll
    for (int r = 1; r < 16; ++r) pmax = fmaxf(pmax, p0[r]);
#pragma unroll
    for (int r = 0; r < 16; ++r) pmax = fmaxf(pmax, p1[r]);
    { auto rr = __builtin_amdgcn_permlane32_swap(__float_as_uint(pmax), __float_as_uint(pmax), false, false);
      pmax = fmaxf(__uint_as_float(rr[0]), __uint_as_float(rr[1])); }
    if (__builtin_expect(__all((pmax - m_reg) * SCALE <= THR), 1)) { mn = m_reg; alpha = 1.f; }
    else { mn = fmaxf(m_reg, pmax); alpha = __builtin_amdgcn_exp2f((m_reg - mn) * C2); m_reg = mn; }
    const float mnL = -mn * C2;
#pragma unroll
    for (int r = 0; r < 16; ++r) p0[r] = fmaf(p0[r], C2, mnL);
#pragma unroll
    for (int r = 0; r < 16; ++r) p1[r] = fmaf(p1[r], C2, mnL);
#pragma unroll
    for (int r = 0; r < 16; ++r) p0[r] = __builtin_amdgcn_exp2f(p0[r]);
}
__device__ __forceinline__ void finishSM(f32x16& p0, f32x16& p1, float alpha, float& l_reg, bf16x8& pa0, bf16x8& pa1, bf16x8& pa2, bf16x8& pa3) {
#pragma unroll
    for (int r = 0; r < 16; ++r) p1[r] = __builtin_amdgcn_exp2f(p1[r]);
    float ps = 0;
#pragma unroll
    for (int r = 0; r < 16; ++r) ps += p0[r];
#pragma unroll
    for (int r = 0; r < 16; ++r) ps += p1[r];
    { auto rr = __builtin_amdgcn_permlane32_swap(__float_as_uint(ps), __float_as_uint(ps), false, false);
      ps = __uint_as_float(rr[0]) + __uint_as_float(rr[1]); }
    l_reg = l_reg * alpha + ps;
#define PK4(P, B_, OUT) do { unsigned a0 = cvtpk(P[B_+0], P[B_+1]), a1 = cvtpk(P[B_+2], P[B_+3]);                          \
        unsigned b0 = cvtpk(P[B_+4], P[B_+5]), b1 = cvtpk(P[B_+6], P[B_+7]);                                             \
        auto r0 = __builtin_amdgcn_permlane32_swap(a0, b0, false, false); auto r1 = __builtin_amdgcn_permlane32_swap(a1, b1, false, false); \
        v4u w = {r0[0], r1[0], r0[1], r1[1]}; OUT = __builtin_bit_cast(bf16x8, w); } while (0)
    PK4(p0, 0, pa0); PK4(p0, 8, pa1); PK4(p1, 0, pa2); PK4(p1, 8, pa3);
#undef PK4
}
template <int KB>
__device__ __forceinline__ void qkt(f32x16& p0, f32x16& p1, const LAS unsigned char* K_lds, int r32, int hi, const bf16x8* qr, bool act) {
    if (!act) { const float NEG = -__builtin_inff();
#pragma unroll
        for (int r = 0; r < 16; ++r) { p0[r] = NEG; p1[r] = NEG; } return; }
    p0 = f32x16{}; p1 = f32x16{};
    const LAS unsigned char* kb[4];
#pragma unroll
    for (int dd = 0; dd < 4; ++dd) kb[dd] = K_lds + KB * SHM_K + KSWZ(r32, (dd * 16 + hi * 8) * 2);
#pragma unroll
    for (int d0 = 0; d0 < 8; ++d0) { const LAS unsigned char* a = kb[d0 & 3] + (d0 >> 2) * 128;
        bf16x8 b0 = *reinterpret_cast<const LAS bf16x8*>(a);
        bf16x8 b1 = *reinterpret_cast<const LAS bf16x8*>(a + 32 * 256);
        p0 = __builtin_amdgcn_mfma_f32_32x32x16_bf16(b0, qr[d0], p0, 0, 0, 0);
        p1 = __builtin_amdgcn_mfma_f32_32x32x16_bf16(b1, qr[d0], p1, 0, 0, 0); }
}
template <int VB>
__device__ __forceinline__ void pv_tile(f32x16* o, int vb0, bf16x8 pa0, bf16x8 pa1, bf16x8 pa2, bf16x8 pa3, bool act) {
    if (!act) return;
#define TRRD(dst, off) asm volatile("ds_read_b64_tr_b16 %0, %1 offset:%2" : "=&v"(dst) : "v"(vb0), "i"(off) : "memory")
#define PV_D0(d0) do { s16x4 l0, l1, l2, l3, h0, h1, h2, h3; constexpr int b_ = VB * SHM_V + v_rd_off(d0, 0, 0); \
        TRRD(l0, b_); TRRD(h0, b_ + 2048); TRRD(l1, b_ + 4096); TRRD(h1, b_ + 6144); TRRD(l2, b_ + 8192); TRRD(h2, b_ + 10240); TRRD(l3, b_ + 12288); TRRD(h3, b_ + 14336); \
        asm volatile("s_waitcnt lgkmcnt(0)" ::: "memory"); SBAR();   \
        o[d0] = __builtin_amdgcn_mfma_f32_32x32x16_bf16(pa0, (bf16x8){l0[0], l0[1], l0[2], l0[3], h0[0], h0[1], h0[2], h0[3]}, o[d0], 0, 0, 0);   \
        o[d0] = __builtin_amdgcn_mfma_f32_32x32x16_bf16(pa1, (bf16x8){l1[0], l1[1], l1[2], l1[3], h1[0], h1[1], h1[2], h1[3]}, o[d0], 0, 0, 0);   \
        o[d0] = __builtin_amdgcn_mfma_f32_32x32x16_bf16(pa2, (bf16x8){l2[0], l2[1], l2[2], l2[3], h2[0], h2[1], h2[2], h2[3]}, o[d0], 0, 0, 0);   \
        o[d0] = __builtin_amdgcn_mfma_f32_32x32x16_bf16(pa3, (bf16x8){l3[0], l3[1], l3[2], l3[3], h3[0], h3[1], h3[2], h3[3]}, o[d0], 0, 0, 0); } while (0)
    PV_D0(0); PV_D0(1); PV_D0(2); PV_D0(3);
#undef PV_D0
#undef TRRD
}
struct BlockRef { const bf16* Q; const bf16* K; const bf16* V; int P0, mode, orow, h; };
struct Seam { bf16x8 qr[8]; bf16x8 st_v0, st_v1, st_k0, st_k1; };
__device__ __forceinline__ GAS char* uni(const void* p) { const unsigned long long b = (unsigned long long)p; const unsigned lo = __builtin_amdgcn_readfirstlane((unsigned)b), hi = __builtin_amdgcn_readfirstlane((unsigned)(b >> 32)); return (GAS char*)(((unsigned long long)hi << 32) | lo); }
#define ROW(p, k0, rr) (uni((const char*)(p) + (size_t)((k0) + (rr)) * (PITCH * 2)) + loff)
#define VMW() asm volatile("s_waitcnt vmcnt(0)" ::: "memory")
#define VMWN(n) asm volatile("s_waitcnt vmcnt(%0)" :: "i"(n) : "memory")
#define LD8(p) (*(const GAS bf16x8*)(p))
#define SLOAD_H(Kp, Vp, k0) do { S.st_v0 = LD8(ROW(Vp, k0, 0)); S.st_v1 = LD8(ROW(Vp, k0, 32)); S.st_k0 = LD8(ROW(Kp, k0, 0)); S.st_k1 = LD8(ROW(Kp, k0, 32)); } while (0)
#define SWRITE_HK(bf) do { *(LAS bf16x8*)(K_lds + (bf) * SHM_K + kws) = S.st_k0; *(LAS bf16x8*)(K_lds + (bf) * SHM_K + kws + 32 * 256) = S.st_k1; } while (0)
#define SWRITE_HV(bf) do { *(LAS bf16x8*)(V_lds + (bf) * SHM_V + vst0) = S.st_v0; *(LAS bf16x8*)(V_lds + (bf) * SHM_V + vst1) = S.st_v1; } while (0)
#define SWRITE_H(bf) do { SWRITE_HV(bf); SWRITE_HK(bf); } while (0)
__device__ __forceinline__ void prime(const BlockRef& cur, LAS unsigned char* lds, Seam& S) {
    const int tid = opaque_tid(), wid = __builtin_amdgcn_readfirstlane(tid >> 6), lane = tid & 63, r32 = lane & 31, hi = lane >> 5;
    const int sr = tid >> 4, sc = (tid & 15) * 8, kws = KSWZ(sr, sc * 2); LAS unsigned char* K_lds = lds + A_K;
    const unsigned loff = (unsigned)(sr * PITCH + sc) * 2u, qoff = (unsigned)(r32 * PITCH + hi * 8) * 2u;
#pragma unroll
    for (int d0 = 0; d0 < 8; ++d0) S.qr[d0] = LD8(uni(cur.Q + (size_t)(wid * QBLK) * PITCH) + qoff + d0 * 32);
    SLOAD_H(cur.K, cur.V, 0); VMW(); SWRITE_HK(0);
    __syncthreads();
}
__device__ __forceinline__ void block(const BlockRef& cur, const BlockRef& nxt, LAS unsigned char* lds, Seam& S, float lam, const float* subln, float* stash, bf16* OB) {
    const int tid = opaque_tid(), wid = __builtin_amdgcn_readfirstlane(tid >> 6), lane = tid & 63, r32 = lane & 31, hi = lane >> 5;
    const int NT = cur.P0 / KVBLK + 4;
    const int qe = (cur.P0 + wid * QBLK) | 63;
    LAS unsigned char* V_lds = lds + A_V; LAS unsigned char* K_lds = lds + A_K;
    LAS float* ws = (LAS float*)(lds + A_WS) + wid * 64; LAS float* li_l = ws; LAS float* al_l = ws + 32;
    float m_reg = -1e30f, l_reg = 0; f32x16 o[4] = {};
    const int sr = tid >> 4, sc = (tid & 15) * 8, vst0 = v_st(sr, sc), vst1 = v_st(32 + sr, sc), kws = KSWZ(sr, sc * 2);
    const unsigned loff = (unsigned)(sr * PITCH + sc) * 2u, qoff = (unsigned)(r32 * PITCH + hi * 8) * 2u;
    const int vb0 = (int)(unsigned)(uintptr_t)V_lds + v_rd_base(lane);
    const bf16* Kh = cur.K; const bf16* Vh = cur.V;
#define RESC(a) do { if (__any((a) < 1.f)) { if (hi == 0) al_l[r32] = (a); asm volatile("s_waitcnt lgkmcnt(0)" ::: "memory");              \
                     for (int d_ = 0; d_ < 4; ++d_) for (int r = 0; r < 16; ++r) o[d_][r] *= al_l[crow(r, hi)]; } } while (0)
#define KBASE(t) ((t) * KVBLK)
#define ACT(t) (KBASE(t) <= qe)
#define SEAM_K0() do { VMWN(8); SWRITE_HK(0); SBAR(); } while (0)
    f32x16 pA0, pA1, pB0, pB1; float mnA, mnB, alA, alB; bf16x8 pa0, pa1, pa2, pa3;
    SWRITE_HV(0); SBAR();
    if (NT > 1) SLOAD_H(Kh, Vh, KBASE(1));
    SBAR(); qkt<0>(pA0, pA1, K_lds, r32, hi, S.qr, ACT(0));
    partialSM(pA0, pA1, m_reg, mnA, alA);
    if (NT > 1) { VMW(); SWRITE_H(1); }
    __syncthreads();
#define HALF_STEP(PX0, PX1, mnX, alX, PY0, PY1, alY, t, KB, VB, SB) do {                                                      \
        SBAR(); qkt<KB>(PX0, PX1, K_lds, r32, hi, S.qr, ACT(t));                                             \
        finishSM(PY0, PY1, alY, l_reg, pa0, pa1, pa2, pa3); SBAR();                                                           \
        if ((t) + 1 < NT) { SLOAD_H(Kh, Vh, KBASE((t) + 1)); SBAR(); }                                               \
        pv_tile<VB>(o, vb0, pa0, pa1, pa2, pa3, ACT((t) - 1)); partialSM(PX0, PX1, m_reg, mnX, alX);                                        \
        __syncthreads();                                                                                                      \
        if ((t) + 1 < NT) { VMW(); SWRITE_H(SB); }                                                                          \
        RESC(alX); __syncthreads(); } while (0)
    for (int t = 1; t + 1 < NT; t += 2) {
        HALF_STEP(pB0, pB1, mnB, alB, pA0, pA1, alA, t, 1, 0, 0);
        HALF_STEP(pA0, pA1, mnA, alA, pB0, pB1, alB, t + 1, 0, 1, 1);
    }
    SBAR(); qkt<1>(pB0, pB1, K_lds, r32, hi, S.qr, ACT(NT - 1)); SBAR();
    SLOAD_H(nxt.K, nxt.V, 0); SBAR();
#pragma unroll
    for (int d0 = 0; d0 < 8; ++d0) S.qr[d0] = LD8(uni(nxt.Q + (size_t)(wid * QBLK) * PITCH) + qoff + d0 * 32);
    SBAR();
    finishSM(pA0, pA1, alA, l_reg, pa0, pa1, pa2, pa3); SBAR();
    pv_tile<0>(o, vb0, pa0, pa1, pa2, pa3, ACT(NT - 2));
    partialSM(pB0, pB1, m_reg, mnB, alB); __syncthreads(); RESC(alB);
    finishSM(pB0, pB1, alB, l_reg, pa0, pa1, pa2, pa3); SBAR(); pv_tile<1>(o, vb0, pa0, pa1, pa2, pa3, ACT(NT - 1));
    SBAR(); SEAM_K0();
    if (hi == 0) li_l[r32] = l_reg; asm volatile("s_waitcnt lgkmcnt(0)" ::: "memory");
    float rli[16];
#pragma unroll
    for (int r = 0; r < 16; ++r) rli[r] = __builtin_amdgcn_rcpf(li_l[crow(r, hi)]);
    GAS char* stb = uni(stash + ((size_t)(blockIdx.x * NWAVES + wid) * ST_PER_LANE) * 64);
    const unsigned sl = (unsigned)lane * 4u;
#define ST_AT(idx) (*(GAS float*)(stb + (size_t)(idx) * 256 + sl))
#define MFENCE() asm volatile("" ::: "memory")
    const int mode = cur.mode;
    if ((mode & 1) == 0) {
#pragma unroll
        for (int d0 = 0; d0 < 4; ++d0) {
#pragma unroll
            for (int r = 0; r < 16; ++r) ST_AT(d0 * 16 + r) = o[d0][r] * rli[r];
            MFENCE(); }
    } else if (mode == 1) {
        float ssp[16];
#pragma unroll
        for (int r = 0; r < 16; ++r) ssp[r] = 0.f;
#pragma unroll
        for (int d0 = 0; d0 < 4; ++d0) { float t2[16];
#pragma unroll
            for (int r = 0; r < 16; ++r) t2[r] = ST_AT(d0 * 16 + r);
#pragma unroll
            for (int r = 0; r < 16; ++r) { const float x = o[d0][r] * rli[r] - lam * t2[r]; ST_AT(64 + d0 * 16 + r) = x; ssp[r] += x * x; }
            MFENCE(); }
#pragma unroll
        for (int r = 0; r < 16; ++r) ST_AT(128 + r) = ssp[r];
    } else {
        float ssp[16];
#pragma unroll
        for (int r = 0; r < 16; ++r) ssp[r] = ST_AT(128 + r);
#pragma unroll
        for (int d0 = 0; d0 < 4; ++d0) { float t2[16];
#pragma unroll
            for (int r = 0; r < 16; ++r) t2[r] = ST_AT(d0 * 16 + r);
#pragma unroll
            for (int r = 0; r < 16; ++r) { const float x = o[d0][r] * rli[r] - lam * t2[r]; o[d0][r] = x; ssp[r] += x * x; }
            MFENCE(); }
#pragma unroll
        for (int r = 0; r < 16; ++r) { float q = ssp[r]; q += __shfl_xor(q, 1); q += __shfl_xor(q, 2); q += __shfl_xor(q, 4); q += __shfl_xor(q, 8); q += __shfl_xor(q, 16);
            ssp[r] = __builtin_amdgcn_rsqf(q * (1.0f / 256.0f) + EPS) * (1.0f - LAMBDA_INIT); }
        GAS char* Owb = uni(OB + (size_t)(cur.orow + wid * QBLK) * DM + cur.h * 256);
        const unsigned ol = (unsigned)(4 * hi * DM + r32) * 2u;
#pragma unroll
        for (int d0 = 0; d0 < 4; ++d0) { const float g1 = subln[128 + d0 * 32 + r32], g0 = subln[d0 * 32 + r32];
#pragma unroll
            for (int r = 0; r < 16; ++r) { const unsigned ro = ol + (unsigned)(((r & 3) + 8 * (r >> 2)) * DM + d0 * 32) * 2u;
                const float v1 = o[d0][r] * ssp[r] * g1, v0 = ST_AT(64 + d0 * 16 + r) * ssp[r] * g0;
                const float v1n = __shfl_xor(v1, 1), v0n = __shfl_xor(v0, 1);
                if ((r32 & 1) == 0) { *(GAS unsigned*)(Owb + ro + 256) = cvtpk(v1, v1n); *(GAS unsigned*)(Owb + ro) = cvtpk(v0, v0n); }
                if ((r & 3) == 3) MFENCE(); } }
    }
#undef ST_AT
#undef MFENCE
    __syncthreads();
#undef RESC
#undef KBASE
#undef ACT
#undef SEAM_K0
#undef HALF_STEP
}
#undef SLOAD_H
#undef SWRITE_HK
#undef SWRITE_HV
#undef SWRITE_H

__device__ __forceinline__ BlockRef decode(int k, int c, int G, const bf16* Qb, const bf16* Kb, const bf16* Vb) {
    const int L = c + (k >> 3) * G, sub = k & 7, pass = sub >> 2, run = sub & 3, bh = L >> 2, x = L & 3, qb = pass ? 7 - x : x, b = bh >> 3, h = bh & 7;
    const int mapj = (run & 1) ? 0 : 1, vh = run >> 1, hv = 2 * h + mapj;
    BlockRef r; r.Q = Qb + (size_t)(b * SEQ + qb * QB) * DM + hv * 128; r.K = Kb + (size_t)(b * SEQ) * DM + hv * 128; r.V = Vb + (size_t)(b * SEQ) * DM + h * 256 + vh * 128;
    r.P0 = qb * QB; r.mode = run; r.orow = b * SEQ + qb * QB; r.h = h; return r;
}

constexpr int B2_V = 0, B2_K = 32768, B2_Q = 69632;
static_assert(B2_Q + 8 * 32 * 136 * 2 <= LDSCTL_OFF && A_WS + 2048 <= B2_Q, "block2 LDS map");
__device__ __forceinline__ void block2(const BlockRef& cur, LAS unsigned char* lds, float lam, const float* subln, float* stash, bf16* OB) {
    const int tid = opaque_tid(), wid = __builtin_amdgcn_readfirstlane(tid >> 6), lane = tid & 63, r32 = lane & 31, hi = lane >> 5;
    const int NT = cur.P0 / 32 + 8;
    const int qe = (cur.P0 + wid * QBLK) | 63;
    LAS unsigned char* V_lds = lds + B2_V; LAS unsigned char* K_lds = lds + B2_K;
    LAS float* ws = (LAS float*)(lds + A_WS) + wid * 64; LAS float* li_l = ws; LAS float* al_l = ws + 32;
    const int sr = tid >> 4, sc = (tid & 15) * 8, vst = v_st(sr, sc), kws = KSWZ(sr, sc * 2);
    const unsigned loff = (unsigned)(sr * PITCH + sc) * 2u;
    const int vb0 = (int)(unsigned)(uintptr_t)V_lds + v_rd_base(lane);
    int kb[4];
#pragma unroll
    for (int dd = 0; dd < 4; ++dd) kb[dd] = KSWZ(r32, (dd * 16 + hi * 8) * 2);
    LAS unsigned short* QL = (LAS unsigned short*)(lds + B2_Q) + wid * (32 * 136);
    { const GAS char* qg = uni(cur.Q + (size_t)(wid * QBLK) * PITCH);
#pragma unroll
      for (int p = 0; p < 8; ++p) { const int id = lane + 64 * p, row = id >> 4, ch = id & 15;
          *(LAS bf16x8*)(QL + row * 136 + ch * 8) = LD8(qg + (size_t)row * (PITCH * 2) + ch * 16); } }
    const LAS unsigned short* qrow = QL + r32 * 136 + hi * 8;
    float m_reg = -1e30f, l_reg = 0.f; f32x16 o0[4] = {}, o1[4] = {};
    unsigned gK, gV;
    { const int o = wid * 1024 + lane * 16;
      { const int row = o >> 8, cb = (o & 255) ^ ((row & 7) << 4); gK = (unsigned)(row * (PITCH * 2) + cb); }
      { const int sub = o >> 9, kh = sub >> 2, c5 = sub & 3, rem = (o & 511) >> 1, kk = kh * 8 + (rem >> 5), c = c5 * 32 + (rem & 31);
        const int k = (kk & ~0xC) | ((kk & 4) << 1) | ((kk & 8) >> 1); gV = (unsigned)(k * (PITCH * 2) + c * 2); } }
#define B2_LOAD(t, bf) do { const GAS char* kt_ = uni((const char*)cur.K + (size_t)(32 * (t)) * (PITCH * 2)); const GAS char* vt_ = uni((const char*)cur.V + (size_t)(32 * (t)) * (PITCH * 2)); \
        __builtin_amdgcn_global_load_lds((const GAS unsigned*)(kt_ + gK), (LAS unsigned*)(K_lds + (bf) * 8192 + wid * 1024), 16, 0, 0); \
        __builtin_amdgcn_global_load_lds((const GAS unsigned*)(vt_ + gV), (LAS unsigned*)(V_lds + (bf) * 16384 + wid * 1024), 16, 0, 0); \
        __builtin_amdgcn_global_load_lds((const GAS unsigned*)(vt_ + gV + 256), (LAS unsigned*)(V_lds + (bf) * 16384 + 8192 + wid * 1024), 16, 0, 0); } while (0)
#define B2_TRRD(dst, off) asm volatile("ds_read_b64_tr_b16 %0, %1 offset:%2" : "=&v"(dst) : "v"(vb0), "i"(off) : "memory")
#define B2_RD16(l0, h0, l1, h1, BF, HALF) do { constexpr int b_ = (BF) * 16384 + (HALF) * 8192; \
        B2_TRRD(l0[0], b_); B2_TRRD(h0[0], b_ + 2048); B2_TRRD(l1[0], b_ + 4096); B2_TRRD(h1[0], b_ + 6144); \
        B2_TRRD(l0[1], b_ + 512); B2_TRRD(h0[1], b_ + 512 + 2048); B2_TRRD(l1[1], b_ + 512 + 4096); B2_TRRD(h1[1], b_ + 512 + 6144); \
        B2_TRRD(l0[2], b_ + 1024); B2_TRRD(h0[2], b_ + 1024 + 2048); B2_TRRD(l1[2], b_ + 1024 + 4096); B2_TRRD(h1[2], b_ + 1024 + 6144); \
        B2_TRRD(l0[3], b_ + 1536); B2_TRRD(h0[3], b_ + 1536 + 2048); B2_TRRD(l1[3], b_ + 1536 + 4096); B2_TRRD(h1[3], b_ + 1536 + 6144); } while (0)
#define B2_MM8(oo, l0, h0, l1, h1) do { _Pragma("unroll") for (int d0 = 0; d0 < 4; ++d0) { \
        oo[d0] = __builtin_amdgcn_mfma_f32_32x32x16_bf16(pa0, (bf16x8){l0[d0][0], l0[d0][1], l0[d0][2], l0[d0][3], h0[d0][0], h0[d0][1], h0[d0][2], h0[d0][3]}, oo[d0], 0, 0, 0); \
        oo[d0] = __builtin_amdgcn_mfma_f32_32x32x16_bf16(pa1, (bf16x8){l1[d0][0], l1[d0][1], l1[d0][2], l1[d0][3], h1[d0][0], h1[d0][1], h1[d0][2], h1[d0][3]}, oo[d0], 0, 0, 0); } } while (0)
#define B2_STEP(t, BF) do { \
        if ((t) + 1 < NT) B2_LOAD((t) + 1, (BF) ^ 1);       \
        SBAR(); \
        if (32 * (t) <= qe) { \
            f32x16 p0 = {}; \
            _Pragma("unroll") for (int d0 = 0; d0 < 8; ++d0) { const bf16x8 b0 = *(const LAS bf16x8*)(K_lds + (BF) * 8192 + kb[d0 & 3] + (d0 >> 2) * 128); \
                p0 = __builtin_amdgcn_mfma_f32_32x32x16_bf16(b0, *(const LAS bf16x8*)(qrow + d0 * 16), p0, 0, 0, 0); } \
            float pmax = p0[0]; \
            _Pragma("unroll") for (int r = 1; r < 16; ++r) pmax = fmaxf(pmax, p0[r]); \
            { auto rr = __builtin_amdgcn_permlane32_swap(__float_as_uint(pmax), __float_as_uint(pmax), false, false); pmax = fmaxf(__uint_as_float(rr[0]), __uint_as_float(rr[1])); } \
            float alpha = 1.f; \
            if (!__all((pmax - m_reg) * SCALE <= THR)) { const float mn = fmaxf(m_reg, pmax); alpha = __builtin_amdgcn_exp2f((m_reg - mn) * C2); m_reg = mn; } \
            const float mnL = -m_reg * C2; float ps = 0.f; \
            _Pragma("unroll") for (int r = 0; r < 16; ++r) { p0[r] = __builtin_amdgcn_exp2f(fmaf(p0[r], C2, mnL)); ps += p0[r]; } \
            { auto rr = __builtin_amdgcn_permlane32_swap(__float_as_uint(ps), __float_as_uint(ps), false, false); ps = __uint_as_float(rr[0]) + __uint_as_float(rr[1]); } \
            l_reg = l_reg * alpha + ps; \
            bf16x8 pa0, pa1; \
            { const unsigned a0 = cvtpk(p0[0], p0[1]), a1 = cvtpk(p0[2], p0[3]), b0_ = cvtpk(p0[4], p0[5]), b1_ = cvtpk(p0[6], p0[7]); \
              auto r0 = __builtin_amdgcn_permlane32_swap(a0, b0_, false, false); auto r1 = __builtin_amdgcn_permlane32_swap(a1, b1_, false, false); \
              v4u w = {r0[0], r1[0], r0[1], r1[1]}; pa0 = __builtin_bit_cast(bf16x8, w); } \
            { const unsigned a0 = cvtpk(p0[8], p0[9]), a1 = cvtpk(p0[10], p0[11]), b0_ = cvtpk(p0[12], p0[13]), b1_ = cvtpk(p0[14], p0[15]); \
              auto r0 = __builtin_amdgcn_permlane32_swap(a0, b0_, false, false); auto r1 = __builtin_amdgcn_permlane32_swap(a1, b1_, false, false); \
              v4u w = {r0[0], r1[0], r0[1], r1[1]}; pa1 = __builtin_bit_cast(bf16x8, w); } \
            if (__any(alpha < 1.f)) { if (hi == 0) al_l[r32] = alpha; asm volatile("s_waitcnt lgkmcnt(0)" ::: "memory"); \
                _Pragma("unroll") for (int d_ = 0; d_ < 4; ++d_) _Pragma("unroll") for (int r = 0; r < 16; ++r) { const float f_ = al_l[crow(r, hi)]; o0[d_][r] *= f_; o1[d_][r] *= f_; } \
                asm volatile("s_waitcnt lgkmcnt(0)" ::: "memory"); } \
            SBAR(); \
            { s16x4 al0[4], ah0[4], al1[4], ah1[4], bl0[4], bh0[4], bl1[4], bh1[4]; \
              B2_RD16(al0, ah0, al1, ah1, BF, 0); asm volatile("s_waitcnt lgkmcnt(0)" ::: "memory"); SBAR(); \
              B2_RD16(bl0, bh0, bl1, bh1, BF, 1); SBAR();              \
              B2_MM8(o0, al0, ah0, al1, ah1); SBAR(); \
              asm volatile("s_waitcnt lgkmcnt(0)" ::: "memory"); SBAR(); \
              B2_MM8(o1, bl0, bh0, bl1, bh1); } \
        } \
        SBAR(); \
        VMW(); asm volatile("s_waitcnt lgkmcnt(0)" ::: "memory"); __builtin_amdgcn_s_barrier(); asm volatile("" ::: "memory"); } while (0)
    B2_LOAD(0, 0); VMW();
    __syncthreads();
    for (int t = 0; t < NT; t += 2) { B2_STEP(t, 0); B2_STEP(t + 1, 1); }
    if (hi == 0) li_l[r32] = l_reg; asm volatile("s_waitcnt lgkmcnt(0)" ::: "memory");
    float rli[16];
#pragma unroll
    for (int r = 0; r < 16; ++r) rli[r] = __builtin_amdgcn_rcpf(li_l[crow(r, hi)]);
    GAS char* stb = uni(stash + ((size_t)(blockIdx.x * NWAVES + wid) * ST_PER_LANE) * 64);
    const unsigned sl = (unsigned)lane * 4u;
#define ST_AT(idx) (*(GAS float*)(stb + (size_t)(idx) * 256 + sl))
#define B2_FENCE() do { asm volatile("" ::: "memory"); __builtin_amdgcn_sched_barrier(0); } while (0)
    if (cur.mode == 0) {
#pragma unroll
        for (int d0 = 0; d0 < 4; ++d0) {
#pragma unroll
            for (int r = 0; r < 16; ++r) ST_AT(d0 * 16 + r) = o0[d0][r] * rli[r];
            B2_FENCE();
#pragma unroll
            for (int r = 0; r < 16; ++r) ST_AT(64 + d0 * 16 + r) = o1[d0][r] * rli[r];
            B2_FENCE(); }
    } else {
        float ssp[16];
#pragma unroll
        for (int r = 0; r < 16; ++r) ssp[r] = 0.f;
#pragma unroll
        for (int d0 = 0; d0 < 4; ++d0) {
            { float t2[16];
#pragma unroll
              for (int r = 0; r < 16; ++r) t2[r] = ST_AT(d0 * 16 + r);
#pragma unroll
              for (int r = 0; r < 16; ++r) { const float x = o0[d0][r] * rli[r] - lam * t2[r]; ST_AT(d0 * 16 + r) = x; ssp[r] += x * x; } }
            B2_FENCE();
            { float t3[16];
#pragma unroll
              for (int r = 0; r < 16; ++r) t3[r] = ST_AT(64 + d0 * 16 + r);
#pragma unroll
              for (int r = 0; r < 16; ++r) { const float y = o1[d0][r] * rli[r] - lam * t3[r]; ST_AT(64 + d0 * 16 + r) = y; ssp[r] += y * y; } }
            B2_FENCE(); }
#pragma unroll
        for (int r = 0; r < 16; ++r) { float q = ssp[r]; q += __shfl_xor(q, 1); q += __shfl_xor(q, 2); q += __shfl_xor(q, 4); q += __shfl_xor(q, 8); q += __shfl_xor(q, 16);
            ssp[r] = __builtin_amdgcn_rsqf(q * (1.0f / 256.0f) + EPS) * (1.0f - LAMBDA_INIT); }
        B2_FENCE();
        GAS char* Owb = uni(OB + (size_t)(cur.orow + wid * QBLK) * DM + cur.h * 256);
        const unsigned ol = (unsigned)(4 * hi * DM + r32) * 2u;
#pragma unroll
        for (int half = 0; half < 2; ++half)
#pragma unroll
            for (int d0 = 0; d0 < 4; ++d0) { const float g = subln[half * 128 + d0 * 32 + r32]; float xv[16];
#pragma unroll
                for (int r = 0; r < 16; ++r) xv[r] = ST_AT(half * 64 + d0 * 16 + r);
#pragma unroll
                for (int r = 0; r < 16; ++r) { const unsigned ro = ol + (unsigned)(((r & 3) + 8 * (r >> 2)) * DM + half * 128 + d0 * 32) * 2u;
                    const float v = xv[r] * ssp[r] * g; const float vn = __shfl_xor(v, 1);
                    if ((r32 & 1) == 0) *(GAS unsigned*)(Owb + ro) = cvtpk(v, vn); }
                B2_FENCE(); }
    }
#undef B2_FENCE
#undef ST_AT
    __syncthreads();
#undef B2_LOAD
#undef B2_TRRD
#undef B2_RD16
#undef B2_MM8
#undef B2_STEP
}
__device__ __forceinline__ BlockRef decode2(int k, int c, int G, const bf16* Qb, const bf16* Kb, const bf16* Vb) {
    const int L = c + (k >> 2) * G, sub = k & 3, pass = sub >> 1, m1 = sub & 1, bh = L >> 2, x = L & 3, qb = pass ? 7 - x : x, b = bh >> 3, h = bh & 7;
    const int hv = 2 * h + (m1 ? 0 : 1);
    BlockRef r; r.Q = Qb + (size_t)(b * SEQ + qb * QB) * DM + hv * 128; r.K = Kb + (size_t)(b * SEQ) * DM + hv * 128; r.V = Vb + (size_t)(b * SEQ) * DM + h * 256;
    r.P0 = qb * QB; r.mode = m1; r.orow = b * SEQ + qb * QB; r.h = h; return r;
}

constexpr int SA_ML = 0, SA_FAC = 2048, SA_SSQ = 3072, SA_OBUF = 4096, SA_Q = SA_OBUF + 4 * 32 * 128 * 4;
__device__ __forceinline__ void sample_unit(LAS unsigned char* lds, int s, int h, const Args& a, const bf16* Qb, float* out, bf16* OB, float lam) {
    const int tid = opaque_tid(), wid = __builtin_amdgcn_readfirstlane(tid >> 6), lane = tid & 63, r32 = lane & 31, hi = lane >> 5;
    const int mj = wid >> 2, dh = (wid >> 1) & 1, ks = wid & 1, hv = 2 * h + mj;
    LAS float* ML = (LAS float*)(lds + SA_ML); LAS float* FAC = (LAS float*)(lds + SA_FAC); LAS float* SSQ = (LAS float*)(lds + SA_SSQ); LAS float* OBUF = (LAS float*)(lds + SA_OBUF);
    LAS unsigned short* QL = (LAS unsigned short*)(lds + SA_Q);
    { const int m2 = tid >> 8, row = (tid >> 3) & 31, ch = tid & 7;
#pragma unroll
      for (int p = 0; p < 2; ++p) { const int c8 = (ch + 8 * p) * 8;
          *(LAS v4u*)(QL + (m2 * 32 + row) * 136 + c8) = *(const GAS v4u*)((const GAS bf16*)Qb + (size_t)(MP + DECS * s + row) * DM + (2 * h + m2) * 128 + c8); } }
    LDS_WAIT(); __syncthreads();
    const LAS unsigned short* qrow = QL + (mj * 32 + r32) * 136 + hi * 8;
    float m_reg = -1e30f, l_reg = 0.f; f32x16 o[4] = {};
    const int ntile = ks ? 33 : 32;
    for (int t = 0; t < ntile; ++t) {
        const bool newt = (t == 32);
        const float* Kp = newt ? out + O_K_S + (size_t)(DECS * s) * DM + hv * 128 : a.in[I_CK] + ((size_t)s * PAST + ks * 1024 + t * 32) * DM + hv * 128;
        const float* Vp = newt ? out + O_V_S + (size_t)(DECS * s) * DM + h * 256 + dh * 128 : a.in[I_CV] + ((size_t)s * PAST + ks * 1024 + t * 32) * DM + h * 256 + dh * 128;
        f32x4 kf[8][2]; float vf[2][4][8];
        { const GAS float* kp = (const GAS float*)uni(Kp) + (size_t)r32 * DM + hi * 8;
#pragma unroll
          for (int d0 = 0; d0 < 8; ++d0) { kf[d0][0] = *(const GAS f32x4*)(kp + d0 * 16); kf[d0][1] = *(const GAS f32x4*)(kp + d0 * 16 + 4); }
          const GAS float* vp = (const GAS float*)uni(Vp) + (size_t)(8 * hi) * DM + r32;
#pragma unroll
          for (int k4 = 0; k4 < 2; ++k4)
#pragma unroll
              for (int d0 = 0; d0 < 4; ++d0)
#pragma unroll
                  for (int i = 0; i < 8; ++i) vf[k4][d0][i] = vp[(size_t)(16 * k4 + i) * DM + d0 * 32]; }
        f32x16 p0 = {};
#pragma unroll
        for (int d0 = 0; d0 < 8; ++d0) { const bf16x8 qf = *(const LAS bf16x8*)(qrow + d0 * 16);
            p0 = __builtin_amdgcn_mfma_f32_32x32x16_bf16(pack8(kf[d0][0], kf[d0][1]), qf, p0, 0, 0, 0); }
        float pmax = p0[0];
#pragma unroll
        for (int r = 1; r < 16; ++r) pmax = fmaxf(pmax, p0[r]);
        { auto rr = __builtin_amdgcn_permlane32_swap(__float_as_uint(pmax), __float_as_uint(pmax), false, false); pmax = fmaxf(__uint_as_float(rr[0]), __uint_as_float(rr[1])); }
        float alpha = 1.f;
        if (!__all((pmax - m_reg) * SCALE <= THR)) { const float mn = fmaxf(m_reg, pmax); alpha = __builtin_amdgcn_exp2f((m_reg - mn) * C2); m_reg = mn; }
        const float mnL = -m_reg * C2; float ps = 0.f;
#pragma unroll
        for (int r = 0; r < 16; ++r) { p0[r] = __builtin_amdgcn_exp2f(fmaf(p0[r], C2, mnL)); ps += p0[r]; }
        { auto rr = __builtin_amdgcn_permlane32_swap(__float_as_uint(ps), __float_as_uint(ps), false, false); ps = __uint_as_float(rr[0]) + __uint_as_float(rr[1]); }
        l_reg = l_reg * alpha + ps;
        bf16x8 pa[2];
#pragma unroll
        for (int k4 = 0; k4 < 2; ++k4) { const unsigned a0 = cvtpk(p0[8 * k4 + 0], p0[8 * k4 + 1]), a1 = cvtpk(p0[8 * k4 + 2], p0[8 * k4 + 3]), b0 = cvtpk(p0[8 * k4 + 4], p0[8 * k4 + 5]), b1 = cvtpk(p0[8 * k4 + 6], p0[8 * k4 + 7]);
            auto r0 = __builtin_amdgcn_permlane32_swap(a0, b0, false, false); auto r1 = __builtin_amdgcn_permlane32_swap(a1, b1, false, false);
            v4u w = {r0[0], r1[0], r0[1], r1[1]}; pa[k4] = __builtin_bit_cast(bf16x8, w); }
        if (__any(alpha < 1.f)) { LAS float* al = FAC + wid * 32; if (hi == 0) al[r32] = alpha; asm volatile("s_waitcnt lgkmcnt(0)" ::: "memory");
#pragma unroll
            for (int d_ = 0; d_ < 4; ++d_)
#pragma unroll
                for (int r = 0; r < 16; ++r) o[d_][r] *= al[crow(r, hi)];
            asm volatile("s_waitcnt lgkmcnt(0)" ::: "memory"); }
#pragma unroll
        for (int k4 = 0; k4 < 2; ++k4)
#pragma unroll
            for (int d0 = 0; d0 < 4; ++d0) { const f32x4 lo = {vf[k4][d0][0], vf[k4][d0][1], vf[k4][d0][2], vf[k4][d0][3]}, hi4 = {vf[k4][d0][4], vf[k4][d0][5], vf[k4][d0][6], vf[k4][d0][7]};
                o[d0] = __builtin_amdgcn_mfma_f32_32x32x16_bf16(pa[k4], pack8(lo, hi4), o[d0], 0, 0, 0); }
    }
    if (hi == 0) { ML[(wid * 32 + r32) * 2] = m_reg; ML[(wid * 32 + r32) * 2 + 1] = l_reg; }
    LDS_WAIT(); __syncthreads();
    { const float mp = ML[((wid ^ 1) * 32 + r32) * 2], lp = ML[((wid ^ 1) * 32 + r32) * 2 + 1];
      const float mt = fmaxf(m_reg, mp), fs = __builtin_amdgcn_exp2f((m_reg - mt) * C2), fp = __builtin_amdgcn_exp2f((mp - mt) * C2), lt = l_reg * fs + lp * fp;
      if (hi == 0) FAC[wid * 32 + r32] = fs * __builtin_amdgcn_rcpf(lt); }
    LDS_WAIT();
#pragma unroll
    for (int d0 = 0; d0 < 4; ++d0)
#pragma unroll
        for (int r = 0; r < 16; ++r) o[d0][r] *= FAC[wid * 32 + crow(r, hi)];
    LAS float* ob = OBUF + (size_t)(mj * 2 + dh) * 32 * 128;
    if (ks == 1) {
#pragma unroll
        for (int d0 = 0; d0 < 4; ++d0)
#pragma unroll
            for (int r = 0; r < 16; ++r) ob[crow(r, hi) * 128 + d0 * 32 + r32] = o[d0][r]; }
    LDS_WAIT(); __syncthreads();
    if (ks == 0) {
#pragma unroll
        for (int d0 = 0; d0 < 4; ++d0)
#pragma unroll
            for (int r = 0; r < 16; ++r) o[d0][r] += ob[crow(r, hi) * 128 + d0 * 32 + r32]; }
    LDS_WAIT(); __syncthreads();
    if (ks == 0 && mj == 1) {
#pragma unroll
        for (int d0 = 0; d0 < 4; ++d0)
#pragma unroll
            for (int r = 0; r < 16; ++r) OBUF[(size_t)dh * 32 * 128 + crow(r, hi) * 128 + d0 * 32 + r32] = o[d0][r]; }
    LDS_WAIT(); __syncthreads();
    float ssp[16];
#pragma unroll
    for (int r = 0; r < 16; ++r) ssp[r] = 0.f;
    if (ks == 0 && mj == 0) {
#pragma unroll
        for (int d0 = 0; d0 < 4; ++d0)
#pragma unroll
            for (int r = 0; r < 16; ++r) { const float x = o[d0][r] - lam * OBUF[(size_t)dh * 32 * 128 + crow(r, hi) * 128 + d0 * 32 + r32]; o[d0][r] = x; ssp[r] += x * x; }
#pragma unroll
        for (int r = 0; r < 16; ++r) { float q = ssp[r]; q += __shfl_xor(q, 1); q += __shfl_xor(q, 2); q += __shfl_xor(q, 4); q += __shfl_xor(q, 8); q += __shfl_xor(q, 16);
            if (r32 == 0) SSQ[dh * 32 + crow(r, hi)] = q; } }
    LDS_WAIT(); __syncthreads();
    if (ks == 0 && mj == 0) {
        bf16* Ow = OB + (size_t)(MP + DECS * s) * DM + h * 256 + dh * 128;
#pragma unroll
        for (int r = 0; r < 16; ++r) { const int row = crow(r, hi); ssp[r] = __builtin_amdgcn_rsqf((SSQ[row] + SSQ[32 + row]) * (1.0f / 256.0f) + EPS) * (1.0f - LAMBDA_INIT); }
#pragma unroll
        for (int d0 = 0; d0 < 4; ++d0) { const float g = a.in[I_ATSUBLN][dh * 128 + d0 * 32 + r32];
#pragma unroll
            for (int r = 0; r < 16; ++r) { const float v = o[d0][r] * ssp[r] * g; const float vn = __shfl_xor(v, 1);
                if ((r32 & 1) == 0) *(unsigned*)(Ow + (size_t)crow(r, hi) * DM + d0 * 32 + r32) = cvtpk(v, vn); } } }
    LDS_WAIT(); __syncthreads();
}
#undef ROW
#undef VMW
#undef VMWN
#undef LD8
}

__device__ __forceinline__ void attn_phase(const Ctx& F, const Args& a) {
    const bf16* Qb = (const bf16*)(F.ws + WS_Q); const bf16* Kb = (const bf16*)(F.ws + WS_K); const bf16* Vb = (const bf16*)(F.ws + WS_V); bf16* OB = (bf16*)(F.ws + WS_OB); float* stash = (float*)(F.ws + WS_ST);
    const int lane = opaque_tid() & 63;
    float lam;
    { const float* L = a.in[I_ATLAM]; const float s1 = wave_sum(L[lane] * L[128 + lane] + L[64 + lane] * L[192 + lane]), s2 = wave_sum(L[256 + lane] * L[384 + lane] + L[320 + lane] * L[448 + lane]);
      lam = __expf(s1) - __expf(s2) + LAMBDA_INIT; }
    unsigned* qctr = (unsigned*)(F.ws + WS_CTL) + CW_ATTNQ;
    volatile LAS int* qslot = (volatile LAS int*)(F.lds + MISC_OFF) + 16;
    const int tid0 = opaque_tid();
    for (;;) {
        if (tid0 == 0) *qslot = (int)__hip_atomic_fetch_add(qctr, 1u, __ATOMIC_RELAXED, __HIP_MEMORY_SCOPE_AGENT);
        __syncthreads();
        const int idx = __builtin_amdgcn_readfirstlane(*qslot);
        __syncthreads();
        if (idx >= 1152) break;
        if (idx >= 640 && idx < 768) { const int u = idx - 640; att::sample_unit(F.lds, u >> 3, u & 7, a, Qb, F.out, OB, lam); continue; }
        const int j = idx < 640 ? idx : idx - 128, qb = 7 - (j >> 7), bh = j & 127, b = bh >> 3, h = bh & 7;
#pragma unroll 1
        for (int m1 = 0; m1 < 2; ++m1) { const int hv = 2 * h + (m1 ? 0 : 1);
            att::BlockRef r; r.Q = Qb + (size_t)(b * SEQ + qb * att::QB) * DM + hv * 128; r.K = Kb + (size_t)(b * SEQ) * DM + hv * 128; r.V = Vb + (size_t)(b * SEQ) * DM + h * 256;
            r.P0 = qb * att::QB; r.mode = m1; r.orow = b * SEQ + qb * att::QB; r.h = h;
            att::block2(r, F.lds, lam, a.in[I_ATSUBLN], stash, OB); }
    }
    VM_WAIT(); __syncthreads();
}

#ifndef MK_PH_LO
#define MK_PH_LO 0
#endif
#ifndef MK_PH_HI
#define MK_PH_HI 99
#endif
template <class Epi>
__device__ __forceinline__ void run_gemm(const Ctx& F, const bf16* A, const bf16* Bt, int N, int K, const Epi& E, int M = MT) {
    pg8::Gemm g{A, Bt, M, N, K, K}; pg8::StaticOrder S; S.init(M, N, F.G, (int)blockIdx.x);
    pg8::gemm_phase<Epi, pg8::StaticOrder, PG8_ALIGN, PG8_SP2>(F.lds + RING_OFF, g, S, E);
}
template <int f, class Epi>
__device__ __forceinline__ void run_gemm_tail(const Ctx& F, const bf16* A, const bf16* Bt, int N, int K, const Epi& E, int phase) {
    run_gemm(F, A, Bt, N, K, E, MP);
    const int kc = K / f;
    pg8::Gemm g{A, Bt, MT, N, kc, K}; pg8::TailOrder S; S.init(MP / 256, N, f, kc, F.G, (int)blockIdx.x);
    EpiTail<Epi, f> ET{E, (float*)(F.ws + WS_SLAB), (unsigned*)(F.ws + WS_CTL) + CW_TAIL + phase * 128, kc, N / 256};
    pg8::OneUnit S1;
    if (S.next(0, S1.u)) pg8::gemm_phase<EpiTail<Epi, f>, pg8::OneUnit, PG8_ALIGN, PG8_SP2, true>(F.lds + RING_OFF, g, S1, ET);
}
__device__ __forceinline__ void run_resid_gemm(const Ctx& F, const bf16* A, const bf16* Bt, int K, int f, const EpiResid& E) {
    run_gemm(F, A, Bt, DM, K, E, MP);
    const int kc = K / f;
    pg8::Gemm g{A, Bt, MT, DM, kc, K}; pg8::SplitOrder S; S.init(MP / 256, DM, f, kc, F.G, (int)blockIdx.x);
    EpiSlab ES{(float*)(F.ws + WS_SLAB), kc};
    pg8::gemm_phase<EpiSlab, pg8::SplitOrder, PG8_ALIGN, PG8_SP2>(F.lds + RING_OFF, g, S, ES);
}
__device__ __forceinline__ void ffn_layer(const Ctx& F, const Args& a, const XcdBarrier& bar, int layer, const float* ss_in, float* ss_out) {
    bf16* XB = (bf16*)(F.ws + WS_XB); bf16* H = (bf16*)(F.ws + WS_H); float* UE = (float*)(F.ws + WS_UE);
    { EpiFfnUp E{H, UE, ss_in + RS_OFF, a.in[I_FFNCW] + (size_t)layer * 3 * NUP, a.in[I_FFNCB] + (size_t)layer * NUP};
      run_gemm_tail<2>(F, XB, (const bf16*)(F.ws + (layer ? WS_UP1 : WS_UP0)), NUP, DM, E, 1 + layer); }
    xcd_barrier(bar);
    ffn_fixup(F, a, layer);
    xcd_barrier(bar);
    { EpiResid E{F.out, F.out + (size_t)MP * DM, F.out, XB, ss_out};
      run_resid_gemm(F, H, (const bf16*)(F.ws + (layer ? WS_DN1 : WS_DN0)), DFF, 11, E); }
    xcd_barrier(bar);
    resid_finish(F, F.out + (size_t)MP * DM, 11, ss_out);
    xcd_barrier(bar);
}
__global__ void __launch_bounds__(NWAVES * 64, 2) mk_fwd(Args args) {
    extern __shared__ __attribute__((aligned(16))) unsigned char lds_raw[];
    Ctx F;
    F.lds = (LAS unsigned char*)lds_raw; F.ws = args.ws; F.out = args.out;
    F.G = gridDim.x; { const int bx = blockIdx.x; F.vcu = (F.G % 8 == 0) ? (bx % 8) * (F.G / 8) + bx / 8 : bx; }
    volatile LAS unsigned* MISC = (volatile LAS unsigned*)(F.lds + MISC_OFF);
    for (int u = threadIdx.x; u < (LDS_BYTES - LDSCTL_OFF) / 4; u += NWAVES * 64) ((LAS unsigned*)(F.lds + LDSCTL_OFF))[u] = 0u;
    __syncthreads();
    XcdBarrier bar = xcd_barrier_post((unsigned*)(F.ws + WS_CTL) + CW_BAR, MISC + 8);
    bf16* XB = (bf16*)(F.ws + WS_XB);
    float* SS0 = (float*)(F.ws + WS_SS), *SS1 = (float*)(F.ws + WS_SS + SS_STRIDE), *SS2 = (float*)(F.ws + WS_SS + 2 * SS_STRIDE), *SS3 = (float*)(F.ws + WS_SS + 3 * SS_STRIDE), *SS4 = (float*)(F.ws + WS_SS + 4 * SS_STRIDE);

#ifndef PHM
#define PHM 0xffff
#endif
#ifndef REP_P0
#define REP_P0 1
#endif
#ifndef REP_P2
#define REP_P2 1
#endif
#ifndef REP_P7
#define REP_P7 1
#endif
    for (int rep = 0; rep < REP_P0; ++rep) { if (rep) { VM_WAIT(); __syncthreads(); } p0_prologue(F, args); }
    xcd_barrier(bar);
#ifndef REP_P1
#define REP_P1 1
#endif
    for (int rep = 0; rep < REP_P1; ++rep) { if (rep) { VM_WAIT(); __syncthreads(); } EpiWin E{(bf16*)(F.ws + WS_U), SS0 + RS_OFF}; run_gemm_tail<2>(F, XB, (const bf16*)(F.ws + WS_WIN), 4096, DM, E, 0); }
    xcd_barrier(bar);
    for (int rep = 0; rep < REP_P2; ++rep) { if (rep) { VM_WAIT(); __syncthreads(); } rglru_phase(F, args); }
    xcd_barrier(bar);
    if constexpr (PHM & 8) { EpiResid E{args.in[I_XP], args.in[I_XS], F.out, XB, SS1}; run_resid_gemm(F, (const bf16*)(F.ws + WS_HY), (const bf16*)(F.ws + WS_RGO), DM, 8, E); }
    xcd_barrier(bar);
    resid_finish(F, args.in[I_XS], 8, SS1);
    xcd_barrier(bar);
    if constexpr (PHM & 16) ffn_layer(F, args, bar, 0, SS1, SS2);
    if constexpr (PHM & 32) { EpiQkv E{(bf16*)(F.ws + WS_Q), (bf16*)(F.ws + WS_K), (bf16*)(F.ws + WS_V), F.out, SS2 + RS_OFF}; run_gemm_tail<2>(F, XB, (const bf16*)(F.ws + WS_QKV), NQKV, DM, E, 3); }
    xcd_barrier(bar);
    for (int rep = 0; rep < REP_P7; ++rep) { if (rep) { VM_WAIT(); __syncthreads(); } attn_phase(F, args); }
    xcd_barrier(bar);
    if constexpr (PHM & 128) { EpiResid E{F.out, F.out + (size_t)MP * DM, F.out, XB, SS3}; run_resid_gemm(F, (const bf16*)(F.ws + WS_OB), (const bf16*)(F.ws + WS_ATO), DM, 8, E); }
    xcd_barrier(bar);
    resid_finish(F, F.out + (size_t)MP * DM, 8, SS3);
    xcd_barrier(bar);
    if constexpr (PHM & 256) ffn_layer(F, args, bar, 1, SS3, SS4);
    if constexpr (PHM & 512) final_norm(F, args, SS4);
}

extern "C" void kernel_launch(void* const* d_in, const int* in_sizes, int n_in, void* d_out, int out_size, void* d_ws, size_t ws_size, hipStream_t stream) {
    static int grid = 0;
    if (grid == 0) {
        if (n_in != 26 || in_sizes[0] != MP * DM || (size_t)out_size != O_END || ws_size < WS_END) {
            fprintf(stderr, "kernel_launch: shape mismatch (n_in %d, in0 %d, out %d, ws %zu; need ws >= %zu); nothing launched\n", n_in, n_in > 0 ? in_sizes[0] : -1, out_size, ws_size, (size_t)WS_END); grid = -1; return; }
        int dev = 0, cus = 0, per_cu = 0;
        if (hipGetDevice(&dev) != hipSuccess || hipDeviceGetAttribute(&cus, hipDeviceAttributeMultiprocessorCount, dev) != hipSuccess) { fprintf(stderr, "kernel_launch: device query failed\n"); grid = -1; return; }
        if (hipFuncSetAttribute((const void*)mk_fwd, hipFuncAttributeMaxDynamicSharedMemorySize, LDS_BYTES) != hipSuccess) { fprintf(stderr, "kernel_launch: hipFuncSetAttribute failed\n"); grid = -1; return; }
        if (hipOccupancyMaxActiveBlocksPerMultiprocessor(&per_cu, (const void*)mk_fwd, NWAVES * 64, LDS_BYTES) != hipSuccess || per_cu < 1)
            fprintf(stderr, "kernel_launch: note: occupancy query reports %d workgroups per CU\n", per_cu);
        (void)hipGetLastError();
        grid = cus;
    }
    if (grid < 0) return;
    if (hipMemsetAsync((char*)d_ws + WS_CTL, 0, CTL_ZERO_BYTES, stream) != hipSuccess) { fprintf(stderr, "kernel_launch: memset failed\n"); return; }
    Args a{};
    for (int i = 0; i < 26; ++i) a.in[i] = (const float*)d_in[i];
    a.out = (float*)d_out; a.ws = (unsigned char*)d_ws;
    hipLaunchKernelGGL(mk_fwd, dim3(grid), dim3(NWAVES * 64), LDS_BYTES, stream, a);
    const hipError_t le = hipPeekAtLastError();
    if (le != hipSuccess) fprintf(stderr, "kernel_launch: launch failed: %s\n", hipGetErrorName(le));
}
```

```cpp
#include <hip/hip_runtime.h>
#include <hip/hip_bf16.h>
#include <cstdio>
#include <cstdint>

namespace pg8 {
#define PG8_LAS __attribute__((address_space(3)))
typedef unsigned short bf16_t;
typedef short bf16x8 __attribute__((ext_vector_type(8)));
typedef float f32x4 __attribute__((ext_vector_type(4)));
typedef unsigned u32x4 __attribute__((ext_vector_type(4)));
constexpr int BM = 256, BK = 64, HALF = 128, HTB = HALF * BK * 2  , STAGE_BYTES = 8 * HTB, NXCD = 8, WGM = 4;

__host__ __device__ __forceinline__ int lds_byte(int r, int c) { const int st = (r >> 4) * 2 + (c >> 5), rr = r & 15, cc = c & 31, ob = rr * 64 + cc * 2; return st * 1024 + (ob ^ (((ob >> 9) & 1) << 5)); }
__host__ __device__ __forceinline__ void stage_rc(int b, int& R, int& C) { const int st = b / 1024, sb = b % 1024, swz = sb ^ (((sb >> 9) & 1) << 5); R = (st >> 1) * 16 + swz / 64; C = (st & 1) * 32 + (swz % 64) / 2; }
__host__ __device__ __forceinline__ int perm32(int rho) { const int n = rho >> 4, i = rho & 15; return 8 * (i >> 2) + 4 * n + (i & 3); }

struct Unit { int pm, pn, ko; };
struct Gemm { const bf16_t* A; const bf16_t* Bt; int M, N, K, ldk; };

struct StaticOrder {
    int nM, nN, nwg, G, c;
    __host__ __device__ void init(int M, int N, int G_, int c_) { nM = M / BM; nN = N / BM; nwg = nM * nN; G = G_; c = c_; }
    __host__ __device__ bool next(int i, Unit& u) const {
        const long L = (long)i * G + c; if (L >= nwg) return false;
        int wgid = (int)L; { const int q = nwg / NXCD, r = nwg % NXCD, xcd = wgid % NXCD, off = wgid / NXCD; wgid = (xcd < r ? xcd * (q + 1) : r * (q + 1) + (xcd - r) * q) + off; }
        const int nig = WGM * nN, gid = wgid / nig, fm = gid * WGM, gsz = (nM - fm) < WGM ? (nM - fm) : WGM;
        u.pm = fm + ((wgid % nig) % gsz); u.pn = (wgid % nig) / gsz; u.ko = 0; return true;
    }
    __device__ __forceinline__ void a_ready(const Unit&) const {}
    __device__ __forceinline__ void done(const Unit&) const {}
};
struct SplitOrder {
    int pm0, nN, f, kc, total, G, c;
    __host__ __device__ void init(int pm0_, int N, int f_, int kc_, int G_, int c_) { pm0 = pm0_; nN = N / BM; f = f_; kc = kc_; total = 2 * nN * f; G = G_; c = c_; }
    __host__ __device__ bool next(int i, Unit& u) const { const int L = i * G + c; if (L >= total) return false; const int ks = L % f, r = L / f; u.pn = r % nN; u.pm = pm0 + r / nN; u.ko = ks * kc; return true; }
    __device__ __forceinline__ void a_ready(const Unit&) const {}
    __device__ __forceinline__ void done(const Unit&) const {}
};

template <class Epi, class Sched, bool ALIGN_EPI = false, bool SP2 = false>
__device__ __forceinline__ void gemm_phase(PG8_LAS unsigned char* lds, const Gemm g, const Sched& S, const Epi& E) {
    int tid = threadIdx.x; asm volatile("" : "+v"(tid));
    const int wid = __builtin_amdgcn_readfirstlane(tid >> 6), lane = tid & 63, wr = wid >> 2, wc = wid & 3, fr = lane & 15, fq = lane >> 4;
    const int K = g.ldk, nt = g.K / BK;
    unsigned voffA[2], voffB[2];
#pragma unroll
    for (int i = 0; i < 2; ++i) { int R, C; stage_rc(tid * 16 + i * 8192, R, C); const int Rb = Epi::PERM ? ((R & ~31) + perm32(R & 31)) : R;
        voffA[i] = (unsigned)(R * K + C) * 2u; voffB[i] = (unsigned)(Rb * K + C) * 2u; }
    const size_t kstep = (size_t)(BK * 2);
    const size_t hstep = (size_t)HALF * K * 2;
    const size_t tstep = 2 * hstep;
    const unsigned ldsw = (unsigned)wid * 1024u;
    const int aoff = lds_byte(wr * 64 + fr, fq * 8), boff = lds_byte(wc * 32 + fr, fq * 8);
#define PG8_SA(b, h) (((b) * 2 + (h)) * HTB)
#define PG8_SB(b, h) ((4 + (b) * 2 + (h)) * HTB)
#define PG8_STAGE(bufoff, gbase, voff) do { _Pragma("unroll") for (int _i = 0; _i < 2; ++_i) \
        __builtin_amdgcn_global_load_lds((const unsigned*)((const char*)(gbase) + (voff)[_i]), (PG8_LAS unsigned*)(lds + (bufoff) + ldsw + _i * 8192), 16, 0, 0); } while (0)
#define PG8_LDA(dst, b, h) do { _Pragma("unroll") for (int m = 0; m < 4; ++m) _Pragma("unroll") for (int k = 0; k < 2; ++k) dst[m][k] = *(const PG8_LAS bf16x8*)(lds + PG8_SA(b, h) + aoff + m * 2048 + k * 1024); } while (0)
#define PG8_LDB(dst, b, h) do { _Pragma("unroll") for (int n = 0; n < 2; ++n) _Pragma("unroll") for (int k = 0; k < 2; ++k) dst[n][k] = *(const PG8_LAS bf16x8*)(lds + PG8_SB(b, h) + boff + n * 2048 + k * 1024); } while (0)
#define PG8_MMA(ai, bj, At, Bt) do { __builtin_amdgcn_s_setprio(1); _Pragma("unroll") for (int m = 0; m < 4; ++m) _Pragma("unroll") for (int n = 0; n < 2; ++n) _Pragma("unroll") for (int k = 0; k < 2; ++k) \
        acc[ai][bj][m][n] = __builtin_amdgcn_mfma_f32_16x16x32_bf16(Bt[n][k], At[m][k], acc[ai][bj][m][n], 0, 0, 0); __builtin_amdgcn_s_setprio(0); } while (0)
#define PG8_WAIT_V(n) asm volatile("s_waitcnt vmcnt(" #n ")" ::: "memory")
#define PG8_WAIT_L(n) asm volatile("s_waitcnt lgkmcnt(" #n ")" ::: "memory")
#define PG8_BAR __builtin_amdgcn_s_barrier()
#define PG8_SCHED __builtin_amdgcn_sched_barrier(0)
    Unit cur, nxt; int ui = 0;
    if (!S.next(0, cur)) return;
    f32x4 acc[2][2][4][2];
#pragma unroll
    for (int a = 0; a < 2; ++a)
#pragma unroll
        for (int b = 0; b < 2; ++b)
#pragma unroll
            for (int m = 0; m < 4; ++m)
#pragma unroll
                for (int n = 0; n < 2; ++n) acc[a][b][m][n] = (f32x4){0.f, 0.f, 0.f, 0.f};
    bf16x8 At[4][2], B0[2][2], B1[2][2];
    const char* cA = (const char*)g.A + (size_t)cur.pm * tstep + (size_t)cur.ko * 2; const char* cB = (const char*)g.Bt + (size_t)cur.pn * tstep + (size_t)cur.ko * 2;
    S.a_ready(cur);
    if constexpr (SP2) {
        PG8_STAGE(PG8_SB(0, 0), cB, voffB); PG8_STAGE(PG8_SB(0, 1), cB + hstep, voffB); PG8_STAGE(PG8_SA(0, 0), cA, voffA); PG8_STAGE(PG8_SA(0, 1), cA + hstep, voffA);
        if (wr == 1) PG8_BAR;
        PG8_WAIT_V(2); PG8_BAR;
        PG8_STAGE(PG8_SB(1, 0), cB + kstep, voffB); PG8_STAGE(PG8_SA(1, 0), cA + kstep, voffA); PG8_STAGE(PG8_SB(1, 1), cB + hstep + kstep, voffB);
        PG8_WAIT_V(6); PG8_BAR;
    } else {
        PG8_STAGE(PG8_SB(0, 0), cB, voffB); PG8_STAGE(PG8_SA(0, 0), cA, voffA); PG8_STAGE(PG8_SB(0, 1), cB + hstep, voffB); PG8_STAGE(PG8_SA(0, 1), cA + hstep, voffA);
        if (wr == 1) PG8_BAR;
        PG8_WAIT_V(4); PG8_BAR;
        PG8_STAGE(PG8_SB(1, 0), cB + kstep, voffB); PG8_STAGE(PG8_SA(1, 0), cA + kstep, voffA); PG8_STAGE(PG8_SB(1, 1), cB + hstep + kstep, voffB);
        PG8_WAIT_V(6); PG8_BAR;
    }
    for (;;) {
        const bool has_next = S.next(ui + 1, nxt);
        PG8_LAS unsigned char* const ep = lds + 8 * HTB + (ui & 1) * 5120;
        if constexpr (Epi::PRE) E.prefetch(ep, cur, wid, lane);
        const char* nA = has_next ? (const char*)g.A + (size_t)nxt.pm * tstep + (size_t)nxt.ko * 2 : cA; const char* nB = has_next ? (const char*)g.Bt + (size_t)nxt.pn * tstep + (size_t)nxt.ko * 2 : cB;
        for (int t = 0; t < nt; t += 2) {
            const bool last = (t == nt - 2);
            const char* a1 = cA + (size_t)(t + 1) * kstep;
            const char* a2 = last ? nA : cA + (size_t)(t + 2) * kstep; const char* b2 = last ? nB : cB + (size_t)(t + 2) * kstep;
            const char* a3 = a2 + kstep; const char* b3 = b2 + kstep;
            if (last && has_next) S.a_ready(nxt);
            if constexpr (SP2) {
            PG8_LDB(B0, 0, 0); PG8_LDB(B1, 0, 1); PG8_SCHED; PG8_LDA(At, 0, 0); PG8_STAGE(PG8_SA(1, 1), a1 + hstep, voffA);
            PG8_WAIT_V(8); PG8_WAIT_L(0); PG8_BAR; PG8_MMA(0, 0, At, B0); PG8_MMA(0, 1, At, B1); PG8_BAR; PG8_SCHED;
            PG8_LDA(At, 0, 1); PG8_STAGE(PG8_SB(0, 0), b2, voffB); PG8_STAGE(PG8_SB(0, 1), b2 + hstep, voffB); PG8_STAGE(PG8_SA(0, 0), a2, voffA);
            PG8_WAIT_V(8); PG8_WAIT_L(0); PG8_BAR; PG8_MMA(1, 0, At, B0); PG8_MMA(1, 1, At, B1); PG8_BAR; PG8_SCHED;
            PG8_LDB(B0, 1, 0); PG8_LDB(B1, 1, 1); PG8_SCHED; PG8_LDA(At, 1, 0); PG8_STAGE(PG8_SA(0, 1), a2 + hstep, voffA);
            PG8_WAIT_V(8); PG8_WAIT_L(0); PG8_BAR; PG8_MMA(0, 0, At, B0); PG8_MMA(0, 1, At, B1); PG8_BAR; PG8_SCHED;
            PG8_LDA(At, 1, 1); PG8_STAGE(PG8_SB(1, 0), b3, voffB); PG8_STAGE(PG8_SB(1, 1), b3 + hstep, voffB); PG8_STAGE(PG8_SA(1, 0), a3, voffA);
            PG8_WAIT_V(8); PG8_WAIT_L(0); PG8_BAR; PG8_MMA(1, 0, At, B0); PG8_MMA(1, 1, At, B1); PG8_BAR; PG8_SCHED;
            } else {
            PG8_LDB(B0, 0, 0); PG8_SCHED; PG8_LDA(At, 0, 0); PG8_STAGE(PG8_SA(1, 1), a1 + hstep, voffA);
            PG8_WAIT_L(8); PG8_BAR; PG8_WAIT_L(0); PG8_MMA(0, 0, At, B0); PG8_BAR; PG8_SCHED;
            PG8_LDB(B1, 0, 1); PG8_STAGE(PG8_SB(0, 0), b2, voffB);
            PG8_BAR; PG8_WAIT_L(0); PG8_MMA(0, 1, At, B1); PG8_BAR;
            PG8_LDA(At, 0, 1); PG8_STAGE(PG8_SA(0, 0), a2, voffA);
            PG8_BAR; PG8_WAIT_L(0); PG8_MMA(1, 0, At, B0); PG8_BAR; PG8_SCHED;
            PG8_STAGE(PG8_SB(0, 1), b2 + hstep, voffB);
            PG8_WAIT_V(6); PG8_BAR; PG8_MMA(1, 1, At, B1); PG8_BAR;
            PG8_LDB(B0, 1, 0); PG8_SCHED; PG8_LDA(At, 1, 0); PG8_STAGE(PG8_SA(0, 1), a2 + hstep, voffA);
            PG8_WAIT_L(8); PG8_BAR; PG8_WAIT_L(0); PG8_MMA(0, 0, At, B0); PG8_BAR; PG8_SCHED;
            PG8_LDB(B1, 1, 1); PG8_STAGE(PG8_SB(1, 0), b3, voffB);
            PG8_BAR; PG8_WAIT_L(0); PG8_MMA(0, 1, At, B1); PG8_BAR;
            PG8_LDA(At, 1, 1); PG8_STAGE(PG8_SA(1, 0), a3, voffA);
            PG8_BAR; PG8_WAIT_L(0); PG8_MMA(1, 0, At, B0); PG8_BAR; PG8_SCHED;
            PG8_STAGE(PG8_SB(1, 1), b3 + hstep, voffB);
            PG8_WAIT_V(6); PG8_BAR; PG8_MMA(1, 1, At, B1); PG8_BAR;
            }
        }
        if constexpr (ALIGN_EPI) { if (wr == 0) PG8_BAR; }
        E(acc, cur, wr, wc, fr, fq, ep); S.done(cur);
        if (!has_next) break;
#pragma unroll
        for (int a = 0; a < 2; ++a)
#pragma unroll
            for (int b = 0; b < 2; ++b)
#pragma unroll
                for (int m = 0; m < 4; ++m)
#pragma unroll
                    for (int n = 0; n < 2; ++n) acc[a][b][m][n] = (f32x4){0.f, 0.f, 0.f, 0.f};
        cur = nxt; cA = nA; cB = nB; ++ui;
        if constexpr (ALIGN_EPI) { if (wr == 1) PG8_BAR; }
    }
    PG8_WAIT_V(0);
    if constexpr (!ALIGN_EPI) { if (wr == 0) PG8_BAR; }
    PG8_BAR;
#undef PG8_SA
#undef PG8_SB
#undef PG8_STAGE
#undef PG8_LDA
#undef PG8_LDB
#undef PG8_MMA
#undef PG8_WAIT_V
#undef PG8_WAIT_L
#undef PG8_BAR
#undef PG8_SCHED
}
}

#ifndef PG8_SP2
#define PG8_SP2 true
#endif
#ifndef PG8_ALIGN
#define PG8_ALIGN true
#endif

constexpr int DM = 2048, NBATCH = 16, SEQ = 2048, DECB = 16, DECS = 32, PAST = 2048;
constexpr int MP = NBATCH * SEQ, MS = DECB * DECS, MT = MP + MS;
constexpr int DFF = 5632, NUP = 2 * DFF, NQKV = 3 * DM;
constexpr int NWAVES = 8;
constexpr float EPS = 1e-6f;
constexpr float LAMBDA_INIT = 0.35550906759f;
constexpr size_t O_Y = 0;
constexpr size_t O_RGC_P = (size_t)MT * DM;
constexpr size_t O_RGH_P = O_RGC_P + 16 * 3 * 2048;
constexpr size_t O_K_P = O_RGH_P + 16 * 2048;
constexpr size_t O_V_P = O_K_P + (size_t)MP * DM;
constexpr size_t O_FFN_P = O_V_P + (size_t)MP * DM;
constexpr size_t O_RGC_S = O_FFN_P + 2 * 16 * 2 * NUP;
constexpr size_t O_RGH_S = O_RGC_S + 16 * 3 * 2048;
constexpr size_t O_K_S = O_RGH_S + 16 * 2048;
constexpr size_t O_V_S = O_K_S + (size_t)MS * DM;
constexpr size_t O_FFN_S = O_V_S + (size_t)MS * DM;
constexpr size_t O_END = O_FFN_S + 2 * 16 * 2 * NUP;
static_assert(O_END == 206176256ull && O_V_P - O_K_P == (size_t)MP * DM && O_V_S - O_K_S == (size_t)MS * DM, "d_out size");

constexpr size_t MiB = 1u << 20;
constexpr size_t WS_CTL = 0, CTL_ZERO_BYTES = 1 * MiB;
constexpr size_t WS_WIN = 2 * MiB, WS_RGO = 18 * MiB, WS_QKV = 26 * MiB, WS_ATO = 50 * MiB, WS_UP0 = 58 * MiB, WS_UP1 = 102 * MiB, WS_DN0 = 146 * MiB, WS_DN1 = 168 * MiB, WS_GW = 190 * MiB;
constexpr size_t WS_SS = 192 * MiB, SS_STRIDE = 5 * MiB;
constexpr size_t WS_XB = 218 * MiB;
constexpr size_t WS_BIG = 348 * MiB;
constexpr size_t WS_U = WS_BIG, WS_HY = WS_BIG + 260 * MiB;
constexpr size_t WS_H = WS_BIG, WS_UE = WS_BIG + 358 * MiB;
constexpr size_t WS_Q = WS_BIG, WS_K = WS_BIG + 130 * MiB, WS_V = WS_BIG + 260 * MiB, WS_OB = WS_BIG + 390 * MiB, WS_ST = WS_BIG + 520 * MiB;
constexpr size_t WS_SLAB = WS_BIG + 600 * MiB;
constexpr size_t WS_END = WS_SLAB + 48 * MiB;
constexpr int NCB = 528;
constexpr int ST_PER_LANE = 144;
static_assert((size_t)MT * DFF * 2 <= 358 * MiB && (size_t)NCB * 4 * NUP * 4 <= 100 * MiB && (size_t)256 * 512 * ST_PER_LANE * 4 <= 80 * MiB, "ws map");
constexpr size_t RS_OFF = (size_t)MT * 32;
static_assert((size_t)MT * 33 * 4 <= SS_STRIDE, "rs behind ss");
static_assert((size_t)MT * 32 * 4 <= SS_STRIDE && WS_SS + 5 * SS_STRIDE <= WS_XB && WS_XB + (size_t)MT * DM * 2 <= WS_BIG, "ws map 2");
constexpr int CW_BAR = 4096, CW_ATTNQ = 16384;

constexpr int RING_OFF = 0, RING_BYTES = 131072;
constexpr int LDS_BYTES = 147456;
constexpr int LDSCTL_OFF = LDS_BYTES - 512, MISC_OFF = LDSCTL_OFF + 320;

#define GAS __attribute__((address_space(1)))
#define LAS __attribute__((address_space(3)))
typedef unsigned short bf16;
typedef unsigned v4u __attribute__((ext_vector_type(4)));
typedef unsigned v2u __attribute__((ext_vector_type(2)));
typedef float f32x4 __attribute__((ext_vector_type(4)));
typedef float f32x2 __attribute__((ext_vector_type(2)));
typedef float f32x16 __attribute__((ext_vector_type(16)));
typedef short bf16x8 __attribute__((ext_vector_type(8)));
typedef short s16x4 __attribute__((ext_vector_type(4)));
#define LDS_WAIT() asm volatile("s_waitcnt lgkmcnt(0)" ::: "memory")
#define VM_WAIT() asm volatile("s_waitcnt vmcnt(0)" ::: "memory")
__device__ __forceinline__ unsigned cvtpk(float lo, float hi) { unsigned r; asm volatile("v_cvt_pk_bf16_f32 %0, %1, %2" : "=v"(r) : "v"(lo), "v"(hi)); return r; }
__device__ __forceinline__ float bf2f(unsigned short h) { return __builtin_bit_cast(float, (unsigned)h << 16); }
__device__ __forceinline__ bf16x8 pack8(f32x4 a, f32x4 b) { v4u w = {cvtpk(a[0], a[1]), cvtpk(a[2], a[3]), cvtpk(b[0], b[1]), cvtpk(b[2], b[3])}; return __builtin_bit_cast(bf16x8, w); }
__device__ __forceinline__ float wave_sum(float v) {
#pragma unroll
    for (int o = 1; o < 64; o <<= 1) v += __shfl_xor(v, o);
    return v;
}
__device__ __forceinline__ float gelu_tanh(float x) {
    const float z = x * (0.7978845608f + 0.0356774081f * x * x);
    const float e = __builtin_amdgcn_exp2f(z * -2.885390082f);
    return x * __builtin_amdgcn_rcpf(1.0f + e);
}
__device__ __forceinline__ float sigmoidf_(float x) { return __builtin_amdgcn_rcpf(1.0f + __builtin_amdgcn_exp2f(x * -1.4426950409f)); }
#define FMAC_DPP(c, s, w, CTRL) asm("v_fmac_f32_dpp %0, %1, %2 " CTRL " row_mask:0xf bank_mask:0xf bound_ctrl:1" : "+v"(c) : "v"(s), "v"(w))
__device__ __forceinline__ f32x4 gelu4(f32x4 x) {
    const f32x4 p = (x * x) * -0.10294324f + -2.302208198f;
    const f32x4 q = x * p;
    f32x4 e; e[0] = __builtin_amdgcn_exp2f(q[0]); e[1] = __builtin_amdgcn_exp2f(q[1]); e[2] = __builtin_amdgcn_exp2f(q[2]); e[3] = __builtin_amdgcn_exp2f(q[3]);
    const f32x4 d = e + 1.0f;
    f32x4 r; r[0] = __builtin_amdgcn_rcpf(d[0]); r[1] = __builtin_amdgcn_rcpf(d[1]); r[2] = __builtin_amdgcn_rcpf(d[2]); r[3] = __builtin_amdgcn_rcpf(d[3]);
    return x * r;
}
__device__ __forceinline__ f32x4 gelu4_mul(f32x4 x, f32x4 v) {
    const f32x4 p = (x * x) * -0.10294324f + -2.302208198f;
    const f32x4 q = x * p;
    f32x4 e; e[0] = __builtin_amdgcn_exp2f(q[0]); e[1] = __builtin_amdgcn_exp2f(q[1]); e[2] = __builtin_amdgcn_exp2f(q[2]); e[3] = __builtin_amdgcn_exp2f(q[3]);
    const f32x4 d = e + 1.0f;
    f32x4 r; r[0] = __builtin_amdgcn_rcpf(d[0]); r[1] = __builtin_amdgcn_rcpf(d[1]); r[2] = __builtin_amdgcn_rcpf(d[2]); r[3] = __builtin_amdgcn_rcpf(d[3]);
    return (x * v) * r;
}
#define DPP_F(oldv, src, ctrl, bc) __builtin_bit_cast(float, __builtin_amdgcn_update_dpp(__builtin_bit_cast(int, (float)(oldv)), __builtin_bit_cast(int, (float)(src)), (ctrl), 0xf, 0xf, (bc)))

__device__ __forceinline__ int opaque_tid() { int t = threadIdx.x; asm volatile("" : "+v"(t)); return t; }
#define XB_TMO      128
#define XB_XCNT(j)  (256  + 64 * (j))
#define XB_XSUB(j)  (1280 + 64 * (j))
#define XB_XGEN(j)  (2304 + 64 * (j))
#define XB_TOP      3328
#define XB_TOPGEN   3392
#define XCD_BAR_WORDS 3456
#define XB_SPIN_CAP (1u << 18)

__device__ __forceinline__ unsigned xb_ld(unsigned* p)              { return __hip_atomic_load(p, __ATOMIC_RELAXED, __HIP_MEMORY_SCOPE_AGENT); }
__device__ __forceinline__ unsigned xb_add(unsigned* p, unsigned v) { return __hip_atomic_fetch_add(p, v, __ATOMIC_RELAXED, __HIP_MEMORY_SCOPE_AGENT); }
__device__ __forceinline__ unsigned xb_xcc_id() { return (unsigned)__builtin_amdgcn_s_getreg((3 << 11) | 20) & 0xFu; }
#define XB_SPIN(cond, bar) do { unsigned _sp = 0; while (cond) { __builtin_amdgcn_s_sleep(1); \
    if ((++_sp & 255u) == 0u) { if (xb_ld(&(bar)[XB_TMO])) break; if (_sp > XB_SPIN_CAP) { atomicAdd(&(bar)[XB_TMO], 1u); break; } } } } while (0)

struct XcdBarrier {
    unsigned* bar; unsigned x;
    volatile LAS unsigned* st;
};
__device__ __forceinline__ XcdBarrier xcd_barrier_post(unsigned* bar, volatile LAS unsigned* st) {
    XcdBarrier b; b.bar = bar; b.x = xb_xcc_id(); b.st = st;
    if (threadIdx.x == 0) (void)xb_add(&bar[XB_XCNT(b.x)], 1u);
    return b;
}
__device__ __forceinline__ void xcd_barrier_complete(unsigned* bar, unsigned x, unsigned& nloc, unsigned& nx) {
    const unsigned G = gridDim.x * gridDim.y * gridDim.z;
    unsigned sum, cnt, mine, sp = 0u;
    for (;;) {
        sum = 0u; cnt = 0u; mine = 0u;
#pragma unroll
        for (unsigned j = 0; j < 16; ++j) { const unsigned c = xb_ld(&bar[XB_XCNT(j)]); sum += c; cnt += (c > 0u) ? 1u : 0u; mine = (j == x) ? c : mine; }
        if (sum == G) break;
        __builtin_amdgcn_s_sleep(1);
        if ((++sp & 255u) == 0u) { if (xb_ld(&bar[XB_TMO])) break; if (sp > XB_SPIN_CAP) { atomicAdd(&bar[XB_TMO], 1u); break; } }
    }
    nloc = mine > 0u ? mine : 1u; nx = cnt > 0u ? cnt : 1u;
}
__device__ __forceinline__ void xcd_barrier(const XcdBarrier& b) {
    asm volatile("s_waitcnt vmcnt(0)" ::: "memory");
    __syncthreads();
    if (threadIdx.x == 0) {
        unsigned* bar = b.bar;
        __builtin_amdgcn_s_waitcnt(0);
        unsigned nloc = b.st[0], nx = b.st[1];
        if (nloc == 0u) { xcd_barrier_complete(bar, b.x, nloc, nx); b.st[0] = nloc; b.st[1] = nx; }
        const unsigned old = xb_add(&bar[XB_XSUB(b.x)], 1u);
        const unsigned gen = old / nloc;
        if (old + 1u == (gen + 1u) * nloc) {
            __builtin_amdgcn_fence(__ATOMIC_RELEASE, "agent");
            asm volatile("s_waitcnt vmcnt(0)" ::: "memory");
            const unsigned og = xb_add(&bar[XB_TOP], 1u);
            const unsigned tg = og / nx;
            if (og + 1u == (tg + 1u) * nx) xb_add(&bar[XB_TOPGEN], 1u);
            else XB_SPIN(xb_ld(&bar[XB_TOPGEN]) == tg, bar);
            __builtin_amdgcn_fence(__ATOMIC_ACQUIRE, "agent");
            xb_add(&bar[XB_XGEN(b.x)], 1u);
            asm volatile("s_waitcnt vmcnt(0)" ::: "memory");
        } else {
            XB_SPIN(xb_ld(&bar[XB_XGEN(b.x)]) == gen, bar);
            __builtin_amdgcn_fence(__ATOMIC_ACQUIRE, "agent");
            asm volatile("s_waitcnt vmcnt(0)" ::: "memory");
        }
    }
    __syncthreads();
}

struct Args { const float* in[26]; float* out; unsigned char* ws; };
enum { I_XP = 0, I_XS, I_SRGC, I_SRGH, I_CK, I_CV, I_SFFN, I_RGNORM, I_RGWIN, I_RGCW, I_RGCB, I_RGGW, I_RGGB, I_RGLL, I_RGWOUT, I_ATNORM, I_ATWQKV, I_ATLAM, I_ATSUBLN, I_ATWOUT,
       I_FFNNORM, I_FFNWUP, I_FFNCW, I_FFNCB, I_FFNWDN, I_FINNORM };

__device__ __forceinline__ void p0_transpose_item(const float* W, const float* gain, int K, int N, bf16* WT, int mode, LAS float* scr, int item, int lane) {
    const int nblk = N / 64, kb = item / nblk, nb = item % nblk, k0 = 64 * kb, n0 = 64 * nb;
    const int c = lane & 7;
    f32x4 g0 = {1.f, 1.f, 1.f, 1.f}, g1 = g0;
    if (gain) { g0 = *(const f32x4*)(gain + k0 + 8 * c); g1 = *(const f32x4*)(gain + k0 + 8 * c + 4); }
    float w[64];
    const float* wp = W + (size_t)k0 * N + n0 + lane;
#pragma unroll
    for (int i = 0; i < 64; ++i) w[i] = wp[(size_t)i * N];
#pragma unroll
    for (int i = 0; i < 64; ++i) scr[i * 65 + lane] = w[i];
    LDS_WAIT(); asm volatile("" ::: "memory");
    int r0 = n0;
    if (mode == 1) { const int j = n0 < DFF ? n0 : n0 - DFF; r0 = 256 * (j >> 7) + (n0 < DFF ? 0 : 128) + (j & 127); }
#pragma unroll
    for (int j = 0; j < 8; ++j) { const int n = (lane >> 3) + 8 * j; const LAS float* s = scr + (8 * c) * 65 + n;
        v4u o; o.x = cvtpk(s[0 * 65] * g0[0], s[1 * 65] * g0[1]); o.y = cvtpk(s[2 * 65] * g0[2], s[3 * 65] * g0[3]); o.z = cvtpk(s[4 * 65] * g1[0], s[5 * 65] * g1[1]); o.w = cvtpk(s[6 * 65] * g1[2], s[7 * 65] * g1[3]);
        *(GAS v4u*)(WT + (size_t)(r0 + n) * K + k0 + 8 * c) = o; }
    LDS_WAIT(); asm volatile("" ::: "memory");
}

__device__ __forceinline__ float rstd_from_ss(const float* ss, int row, int fq) {
    const f32x4* p = (const f32x4*)(ss + (size_t)row * 32 + 8 * fq);
    const f32x4 a = p[0], b = p[1];
    float s = ((a[0] + a[1]) + (a[2] + a[3])) + ((b[0] + b[1]) + (b[2] + b[3]));
    s += __shfl_xor(s, 16); s += __shfl_xor(s, 32);
    return __builtin_amdgcn_rsqf(s * (1.0f / DM) + EPS);
}

__device__ __forceinline__ GAS char* uni_f(const void* p) { const unsigned long long b = (unsigned long long)p; const unsigned lo = __builtin_amdgcn_readfirstlane((unsigned)b), hi = __builtin_amdgcn_readfirstlane((unsigned)(b >> 32)); return (GAS char*)(((unsigned long long)hi << 32) | lo); }
typedef f32x4 AccT[2][2][4][2];
struct EpiWin {
    static constexpr bool PERM = true, PRE = true; static constexpr int NST = 16;
    bf16* U; const float* rs;
    __device__ __forceinline__ void prefetch(LAS unsigned char* ep, const pg8::Unit& u, int wid, int lane) const {
        if (wid < 4) __builtin_amdgcn_global_load_lds((const unsigned*)(rs + u.pm * 256 + wid * 64 + lane), (LAS unsigned*)(ep + 4096 + wid * 256), 4, 0, 0);
    }
    __device__ __forceinline__ void operator()(AccT& acc, const pg8::Unit& u, int wr, int wc, int fr_in, int fq_in, LAS unsigned char* ep) const {
        int fr = fr_in, fq = fq_in; asm volatile("" : "+v"(fr), "+v"(fq));
        const int row0 = u.pm * 256 + wr * 64 + fr, col0 = u.pn * 256 + wc * 32 + 8 * fq; const bool act = u.pn < 8;
        const LAS char* rsb = (const LAS char*)ep + 4096 + (wr * 64 + fr) * 4;
        float r[2][4];
#pragma unroll
        for (int ai = 0; ai < 2; ++ai)
#pragma unroll
            for (int m = 0; m < 4; ++m) r[ai][m] = *(const LAS float*)(rsb + (ai * 128 + m * 16) * 4);
#pragma unroll
        for (int ai = 0; ai < 2; ++ai)
#pragma unroll
            for (int m = 0; m < 4; ++m) { const int row = row0 + ai * 128 + m * 16; const float rs_ = r[ai][m];
#pragma unroll
                for (int bj = 0; bj < 2; ++bj) { f32x4 v0 = acc[ai][bj][m][0] * rs_, v1 = acc[ai][bj][m][1] * rs_;
                    if (act) { v0 = gelu4(v0); v1 = gelu4(v1); }
                    v4u w; w.x = cvtpk(v0[0], v0[1]); w.y = cvtpk(v0[2], v0[3]); w.z = cvtpk(v1[0], v1[1]); w.w = cvtpk(v1[2], v1[3]);
                    *(v4u*)(U + (size_t)row * 4096 + col0 + bj * 128) = w; } }
    }
};
struct EpiResid {
    static constexpr bool PERM = true, PRE = false; static constexpr int NST = 48;
    const float* baseP; const float* baseS; float* X; bf16* XB; float* ssout;
    __device__ __forceinline__ void operator()(AccT& acc, const pg8::Unit& u, int wr, int wc, int fr_in, int fq_in, LAS unsigned char*) const {
        int fr = fr_in, fq = fq_in; asm volatile("" : "+v"(fr), "+v"(fq));
        const int row0 = u.pm * 256 + wr * 64 + fr, col0 = u.pn * 256 + wc * 32 + 8 * fq;
        const float* bp0 = (u.pm < 128) ? baseP + (size_t)row0 * DM + col0 : baseS + (size_t)(row0 - MP) * DM + col0;
        f32x4 b[4][2][2];
#define RESID_LD(slot, g) { const float* q_ = bp0 + (size_t)(((g) >> 2) * 128 + ((g) & 3) * 16) * DM; \
            b[slot][0][0] = *(const f32x4*)(q_); b[slot][0][1] = *(const f32x4*)(q_ + 4); b[slot][1][0] = *(const f32x4*)(q_ + 128); b[slot][1][1] = *(const f32x4*)(q_ + 132); }
        RESID_LD(0, 0); RESID_LD(1, 1); RESID_LD(2, 2); RESID_LD(3, 3);
#pragma unroll
        for (int g = 0; g < 8; ++g) { const int ai = g >> 2, m = g & 3, row = row0 + ai * 128 + m * 16; float q = 0.f;
            f32x4 o[2][2];
#pragma unroll
            for (int bj = 0; bj < 2; ++bj) { o[bj][0] = b[g & 3][bj][0] + acc[ai][bj][m][0]; o[bj][1] = b[g & 3][bj][1] + acc[ai][bj][m][1]; }
            if (g + 4 < 8) RESID_LD(g & 3, g + 4);
            asm volatile("" ::: "memory");
#pragma unroll
            for (int bj = 0; bj < 2; ++bj) { const int col = col0 + bj * 128; const f32x4 o0 = o[bj][0], o1 = o[bj][1];
                *(f32x4*)(X + (size_t)row * DM + col) = o0; *(f32x4*)(X + (size_t)row * DM + col + 4) = o1;
                v4u w; w.x = cvtpk(o0[0], o0[1]); w.y = cvtpk(o0[2], o0[3]); w.z = cvtpk(o1[0], o1[1]); w.w = cvtpk(o1[2], o1[3]);
                *(v4u*)(XB + (size_t)row * DM + col) = w;
                q += (o0[0] * o0[0] + o0[1] * o0[1]) + (o0[2] * o0[2] + o0[3] * o0[3]) + (o1[0] * o1[0] + o1[1] * o1[1]) + (o1[2] * o1[2] + o1[3] * o1[3]); }
            q += __shfl_xor(q, 16); q += __shfl_xor(q, 32);
            if (fq == 0) ssout[(size_t)row * 32 + 4 * u.pn + wc] = q; }
#undef RESID_LD
    }
};
struct EpiSlab {
    static constexpr bool PERM = true, PRE = false; static constexpr int NST = 32;
    float* slab; int kc;
    __device__ __forceinline__ void operator()(AccT& acc, const pg8::Unit& u, int wr, int wc, int fr_in, int fq_in, LAS unsigned char*) const {
        int fr = fr_in, fq = fq_in; asm volatile("" : "+v"(fr), "+v"(fq));
        const int ks = u.ko / kc;
        GAS char* base = uni_f(slab + ((size_t)ks * MS + (size_t)(u.pm - 128) * 256 + wr * 64) * DM + u.pn * 256 + wc * 32);
        const unsigned lo = (unsigned)(fr * DM + 8 * fq) * 4u;
#pragma unroll
        for (int ai = 0; ai < 2; ++ai)
#pragma unroll
            for (int m = 0; m < 4; ++m)
#pragma unroll
                for (int bj = 0; bj < 2; ++bj) { GAS char* p = base + lo + (unsigned)((ai * 128 + m * 16) * DM + bj * 128) * 4u;
                    *(GAS f32x4*)p = acc[ai][bj][m][0]; *(GAS f32x4*)(p + 16) = acc[ai][bj][m][1]; }
    }
};
struct EpiQkv {
    static constexpr bool PERM = true, PRE = true; static constexpr int NST = 16;
    bf16* Qb; bf16* Kb; bf16* Vb; float* out; const float* rs;
    __device__ __forceinline__ void prefetch(LAS unsigned char* ep, const pg8::Unit& u, int wid, int lane) const {
        if (wid < 4) __builtin_amdgcn_global_load_lds((const unsigned*)(rs + u.pm * 256 + wid * 64 + lane), (LAS unsigned*)(ep + 4096 + wid * 256), 4, 0, 0);
    }
    __device__ __forceinline__ void operator()(AccT& acc, const pg8::Unit& u, int wr, int wc, int fr_in, int fq_in, LAS unsigned char* ep) const {
        int fr = fr_in, fq = fq_in; asm volatile("" : "+v"(fr), "+v"(fq));
        const int t = u.pn >> 3; const int rl0 = wr * 64 + fr, col0 = (u.pn & 7) * 256 + wc * 32 + 8 * fq;
        bf16* dst = Qb + (size_t)t * ((WS_K - WS_Q) / 2) + (size_t)u.pm * 256 * DM;
        const size_t tk = (size_t)(t == 2 ? 1 : 0);
        float* fo = (u.pm < 128) ? out + O_K_P + tk * ((size_t)MP * DM) + (size_t)u.pm * 256 * DM : out + O_K_S + tk * ((size_t)MS * DM) + (size_t)(u.pm - 128) * 256 * DM;
        const LAS char* rsb = (const LAS char*)ep + 4096 + (wr * 64 + fr) * 4;
        float r[2][4];
#pragma unroll
        for (int ai = 0; ai < 2; ++ai)
#pragma unroll
            for (int m = 0; m < 4; ++m) r[ai][m] = *(const LAS float*)(rsb + (ai * 128 + m * 16) * 4);
#pragma unroll
        for (int ai = 0; ai < 2; ++ai)
#pragma unroll
            for (int m = 0; m < 4; ++m) { const int rl = rl0 + ai * 128 + m * 16; const float rs_ = r[ai][m];
#pragma unroll
                for (int bj = 0; bj < 2; ++bj) { const int col = col0 + bj * 128; const f32x4 v0 = acc[ai][bj][m][0] * rs_, v1 = acc[ai][bj][m][1] * rs_;
                    v4u w; w.x = cvtpk(v0[0], v0[1]); w.y = cvtpk(v0[2], v0[3]); w.z = cvtpk(v1[0], v1[1]); w.w = cvtpk(v1[2], v1[3]);
                    *(v4u*)(dst + (size_t)rl * DM + col) = w;
                    if (t > 0) { *(f32x4*)(fo + (size_t)rl * DM + col) = v0; *(f32x4*)(fo + (size_t)rl * DM + col + 4) = v1; } }
                asm volatile("" ::: "memory"); }
    }
};
struct EpiFfnUp {
    static constexpr bool PERM = true, PRE = true; static constexpr int NST = 32;
    bf16* H; float* UE; const float* rs; const float* cw; const float* cb;
    __device__ __forceinline__ void prefetch(LAS unsigned char* ep, const pg8::Unit& u, int wid, int lane) const {
        const int k = wid >> 1, half = wid & 1;
        const float* src = (k < 3 ? cw + (size_t)k * NUP : cb) + (half ? DFF : 0) + 128 * u.pn + lane;
        __builtin_amdgcn_global_load_lds((const unsigned*)src, (LAS unsigned*)(ep + (k * 256 + half * 128) * 4), 4, 0, 0);
        __builtin_amdgcn_global_load_lds((const unsigned*)(src + 64), (LAS unsigned*)(ep + (k * 256 + half * 128 + 64) * 4), 4, 0, 0);
        if (wid < 4) __builtin_amdgcn_global_load_lds((const unsigned*)(rs + u.pm * 256 + wid * 64 + lane), (LAS unsigned*)(ep + 4096 + wid * 256), 4, 0, 0);
    }
    __device__ __forceinline__ void operator()(AccT& acc, const pg8::Unit& u, int wr, int wc, int fr_in, int fq_in, LAS unsigned char* ep) const {
        int fr = fr_in, fq = fq_in; asm volatile("" : "+v"(fr), "+v"(fq));
        const bool samp = u.pm >= 128; const int colg0 = 128 * u.pn + 32 * wc;
        const LAS char* rsb = (const LAS char*)ep + 4096 + (wr * 64 + fr) * 4;
        float r[2][4];
#pragma unroll
        for (int ai = 0; ai < 2; ++ai)
#pragma unroll
            for (int m = 0; m < 4; ++m) r[ai][m] = *(const LAS float*)(rsb + (ai * 128 + m * 16) * 4);
        const LAS char* cwl = (const LAS char*)ep + (32 * wc + 8 * fq) * 4;
#pragma unroll
        for (int ai = 0; ai < 2; ++ai)
#pragma unroll
            for (int m = 0; m < 4; ++m)
#pragma unroll
                for (int bj = 0; bj < 2; ++bj) { acc[ai][bj][m][0] *= r[ai][m]; acc[ai][bj][m][1] *= r[ai][m]; }
#pragma unroll
        for (int ai = 0; ai < 2; ++ai)
#pragma unroll
            for (int bj = 0; bj < 2; ++bj)
                asm volatile("s_nop 1" : "+v"(acc[ai][bj][0][0]), "+v"(acc[ai][bj][0][1]), "+v"(acc[ai][bj][1][0]), "+v"(acc[ai][bj][1][1]), "+v"(acc[ai][bj][2][0]), "+v"(acc[ai][bj][2][1]), "+v"(acc[ai][bj][3][0]), "+v"(acc[ai][bj][3][1]));
        {
            const unsigned cl = (unsigned)(8 * fq) * 4u;
#pragma unroll
            for (int ai = 0; ai < 2; ++ai)
#pragma unroll
                for (int m = 0; m < 4; ++m) {
                    const bool first = (fr < 2) && (m == 0 || (samp && m == 2)), lastr = (fr >= 14) && (m == 3 || (samp && m == 1));
                    if (first || lastr) { const int slot = first ? fr : fr - 12;
                        const int cbi = samp ? 512 + (u.pm - 128) * 8 + ai * 4 + wr * 2 + (m >> 1) : u.pm * 4 + ai * 2 + wr;
                        GAS char* p = (GAS char*)uni_f(UE + (size_t)cbi * 4 * NUP + colg0) + (unsigned)slot * (NUP * 4u) + cl;
#pragma unroll
                        for (int bj = 0; bj < 2; ++bj) { *(GAS f32x4*)(p + bj * DFF * 4) = acc[ai][bj][m][0]; *(GAS f32x4*)(p + bj * DFF * 4 + 16) = acc[ai][bj][m][1]; } } } }
        GAS char* Hb = (GAS char*)uni_f(H + (size_t)(u.pm * 256 + wr * 64) * DFF + colg0);
        const unsigned hl = (unsigned)(fr * DFF + 8 * fq) * 2u;
#pragma unroll
        for (int n = 0; n < 2; ++n) {
            f32x4 w0[2], w1[2], w2[2], bb[2];
#pragma unroll
            for (int bj = 0; bj < 2; ++bj) { const int c = (bj * 128 + 4 * n) * 4; w0[bj] = *(const LAS f32x4*)(cwl + c); w1[bj] = *(const LAS f32x4*)(cwl + 1024 + c); w2[bj] = *(const LAS f32x4*)(cwl + 2048 + c); bb[bj] = *(const LAS f32x4*)(cwl + 3072 + c); }
#pragma unroll
            for (int ai = 0; ai < 2; ++ai)
#pragma unroll
                for (int m = 0; m < 4; ++m) { f32x4 cv[2];
#pragma unroll
                    for (int bj = 0; bj < 2; ++bj) { cv[bj] = bb[bj] + w2[bj] * acc[ai][bj][m][n];
#pragma unroll
                        for (int i = 0; i < 4; ++i) { float c = cv[bj][i]; const float cur = acc[ai][bj][m][n][i];
                            FMAC_DPP(c, cur, w1[bj][i], "row_shr:1"); FMAC_DPP(c, cur, w0[bj][i], "row_shr:2");
                            if (m > 0) { const float pv = acc[ai][bj][m - 1][n][i]; FMAC_DPP(c, pv, w1[bj][i], "row_shl:15"); FMAC_DPP(c, pv, w0[bj][i], "row_shl:14"); }
                            cv[bj][i] = c; } }
                    v2u w; { const f32x4 h = gelu4_mul(cv[0], cv[1]); w.x = cvtpk(h[0], h[1]); w.y = cvtpk(h[2], h[3]); }
                    *(GAS v2u*)(Hb + hl + (unsigned)((ai * 128 + m * 16) * DFF + 4 * n) * 2u) = w;
                    __builtin_amdgcn_sched_barrier(0); } }
    }
};

struct Ctx {
    LAS unsigned char* lds; unsigned char* ws; float* out; int vcu, G;
};
__device__ __forceinline__ void p0_prologue(const Ctx& F, const Args& a) {
    const int tid = opaque_tid(), lane = tid & 63, wave = __builtin_amdgcn_readfirstlane(tid >> 6);
    LAS float* scr = (LAS float*)(F.lds + RING_OFF + wave * 16640);
    const int gw = F.vcu * NWAVES + wave, NGW = F.G * NWAVES;
    constexpr int I_WIN = (DM / 64) * (4096 / 64), I_RGO = (DM / 64) * (DM / 64), I_QKV = (DM / 64) * (NQKV / 64), I_ATO = I_RGO, I_UP = (DM / 64) * (NUP / 64), I_DN = (DFF / 64) * (DM / 64), I_GW = 2 * 4;
    static_assert(8 * 16640 <= LDSCTL_OFF, "prologue scratch");
    static_assert(RING_BYTES + 2 * 5120 <= LDSCTL_OFF, "epilogue tables behind the GEMM ring");
    constexpr int NITEMS = I_WIN + I_RGO + I_QKV + I_ATO + 2 * I_UP + 2 * I_DN + 16 * I_GW;
    for (int it = gw; it < NITEMS; it += NGW) {
        int r = it;
        if (r < I_WIN) { p0_transpose_item(a.in[I_RGWIN], a.in[I_RGNORM], DM, 4096, (bf16*)(F.ws + WS_WIN), 0, scr, r, lane); continue; } r -= I_WIN;
        if (r < I_RGO) { p0_transpose_item(a.in[I_RGWOUT], nullptr, DM, DM, (bf16*)(F.ws + WS_RGO), 0, scr, r, lane); continue; } r -= I_RGO;
        if (r < I_QKV) { p0_transpose_item(a.in[I_ATWQKV], a.in[I_ATNORM], DM, NQKV, (bf16*)(F.ws + WS_QKV), 0, scr, r, lane); continue; } r -= I_QKV;
        if (r < I_ATO) { p0_transpose_item(a.in[I_ATWOUT], nullptr, DM, DM, (bf16*)(F.ws + WS_ATO), 0, scr, r, lane); continue; } r -= I_ATO;
        if (r < I_UP) { p0_transpose_item(a.in[I_FFNWUP], a.in[I_FFNNORM], DM, NUP, (bf16*)(F.ws + WS_UP0), 1, scr, r, lane); continue; } r -= I_UP;
        if (r < I_UP) { p0_transpose_item(a.in[I_FFNWUP] + (size_t)DM * NUP, a.in[I_FFNNORM] + DM, DM, NUP, (bf16*)(F.ws + WS_UP1), 1, scr, r, lane); continue; } r -= I_UP;
        if (r < I_DN) { p0_transpose_item(a.in[I_FFNWDN], nullptr, DFF, DM, (bf16*)(F.ws + WS_DN0), 0, scr, r, lane); continue; } r -= I_DN;
        if (r < I_DN) { p0_transpose_item(a.in[I_FFNWDN] + (size_t)DFF * DM, nullptr, DFF, DM, (bf16*)(F.ws + WS_DN1), 0, scr, r, lane); continue; } r -= I_DN;
        { const int n = r / I_GW, rr = r % I_GW;
          p0_transpose_item(a.in[I_RGGW] + (size_t)n * 128 * 256, nullptr, 128, 256, (bf16*)(F.ws + WS_GW) + (size_t)n * 256 * 128, 0, scr, rr, lane); }
    }
    bf16* XB = (bf16*)(F.ws + WS_XB); float* rs0 = (float*)(F.ws + WS_SS) + RS_OFF;
    f32x4 v[8];
#pragma unroll
    for (int j = 0; j < 8; ++j) v[j] = (f32x4){0.f, 0.f, 0.f, 0.f};
    int m = gw;
    if (m < MT) { const GAS f32x4* xv = (const GAS f32x4*)((m < MP) ? a.in[I_XP] + (size_t)m * DM : a.in[I_XS] + (size_t)(m - MP) * DM) + lane;
#pragma unroll
        for (int j = 0; j < 8; ++j) v[j] = xv[64 * j]; }
    while (m < MT) {
        const int mn = m + NGW; f32x4 vn[8];
#pragma unroll
        for (int j = 0; j < 8; ++j) vn[j] = (f32x4){0.f, 0.f, 0.f, 0.f};
        if (mn < MT) { const GAS f32x4* xn = (const GAS f32x4*)((mn < MP) ? a.in[I_XP] + (size_t)mn * DM : a.in[I_XS] + (size_t)(mn - MP) * DM) + lane;
#pragma unroll
            for (int j = 0; j < 8; ++j) vn[j] = xn[64 * j]; }
        asm volatile("" ::: "memory");
        float s = 0.f;
#pragma unroll
        for (int j = 0; j < 8; ++j) s += (v[j][0] * v[j][0] + v[j][1] * v[j][1]) + (v[j][2] * v[j][2] + v[j][3] * v[j][3]);
        s = wave_sum(s);
        GAS v2u* o8 = (GAS v2u*)(XB + (size_t)m * DM) + lane;
#pragma unroll
        for (int j = 0; j < 8; ++j) { v2u w; w.x = cvtpk(v[j][0], v[j][1]); w.y = cvtpk(v[j][2], v[j][3]); o8[64 * j] = w; }
        if (lane == 0) rs0[m] = __builtin_amdgcn_rsqf(s * (1.0f / DM) + EPS);
#pragma unroll
        for (int j = 0; j < 8; ++j) v[j] = vn[j];
        m = mn;
    }
}

constexpr int RG_REC = 0, RG_Y = 35840, RG_XCF = 53248, RG_XCB = 87040, RG_HY = 104448;
static_assert(RG_HY + 64 * 136 * 2 <= RING_BYTES, "rglru LDS map");
__device__ __forceinline__ void rglru_phase(const Ctx& F, const Args& a) {
    const int tid = opaque_tid(), lane = tid & 63, wid = __builtin_amdgcn_readfirstlane(tid >> 6), col = lane & 15, quad = lane >> 4;
    LAS float* recf = (LAS float*)(F.lds + RG_REC); LAS unsigned short* ytile = (LAS unsigned short*)(F.lds + RG_Y);
    LAS float* xcf = (LAS float*)(F.lds + RG_XCF); LAS unsigned short* xcb = (LAS unsigned short*)(F.lds + RG_XCB); LAS unsigned short* hyt = (LAS unsigned short*)(F.lds + RG_HY);
    const bf16* U = (const bf16*)(F.ws + WS_U); bf16* HY = (bf16*)(F.ws + WS_HY); const bf16* GWt = (const bf16*)(F.ws + WS_GW);
    for (int unit = blockIdx.x; unit < 512; unit += F.G) {
        const bool samp = unit >= 256; const int uu = samp ? unit - 256 : unit, b = uu >> 4, n = uu & 15;
        const int T = samp ? DECS : SEQ, row0 = samp ? MP + DECS * b : SEQ * b;
        bf16x8 Br[4], Bi[4];
        { const bf16* gw = GWt + (size_t)n * 256 * 128;
#pragma unroll
          for (int ks = 0; ks < 4; ++ks) { Br[ks] = *(const bf16x8*)(gw + (size_t)(16 * wid + col) * 128 + 32 * ks + 8 * quad); Bi[ks] = *(const bf16x8*)(gw + (size_t)(128 + 16 * wid + col) * 128 + 32 * ks + 8 * quad); } }
        const int ch = 128 * n + 16 * wid + col;
        const float gbr = a.in[I_RGGB][n * 256 + 16 * wid + col], gbi = a.in[I_RGGB][n * 256 + 128 + 16 * wid + col];
        const float sp8 = 8.f * log1pf(__expf(-a.in[I_RGLL][ch]));
        float hcar = samp ? a.in[I_SRGH][b * 2048 + ch] : 0.f;
        const int cc = tid & 127, rg4 = tid >> 7, cch = 128 * n + cc;
        const float cw0 = a.in[I_RGCW][cch], cw1 = a.in[I_RGCW][2048 + cch], cw2 = a.in[I_RGCW][4096 + cch], cw3 = a.in[I_RGCW][6144 + cch], cbias = a.in[I_RGCB][cch];
        float* o_rgc = F.out + (samp ? O_RGC_S : O_RGC_P); float* o_rgh = F.out + (samp ? O_RGH_S : O_RGH_P);
        const int r = tid >> 4, c8 = (tid & 15) * 8;
        const bf16* Urec = U + (size_t)row0 * 4096 + 2048 + 128 * n + c8; const bf16* Uy = U + (size_t)row0 * 4096 + 128 * n + c8;
        v4u rraw[3], yraw[2];
#define RG_LOAD(t0_) do { _Pragma("unroll") for (int p = 0; p < 3; ++p) { const int rr = 32 * p + r, t = (t0_) - 3 + rr; rraw[p] = (v4u){0u, 0u, 0u, 0u}; if (rr < 67 && t >= 0 && t < T) rraw[p] = *(const v4u*)(Urec + (size_t)t * 4096); } \
        _Pragma("unroll") for (int p = 0; p < 2; ++p) { const int t = (t0_) + 32 * p + r; yraw[p] = (v4u){0u, 0u, 0u, 0u}; if (t < T) yraw[p] = *(const v4u*)(Uy + (size_t)t * 4096); } } while (0)
        RG_LOAD(0);
        for (int t0 = 0; t0 < T; t0 += 64) {
#pragma unroll
            for (int p = 0; p < 3; ++p) { const int rr = 32 * p + r; if (rr < 67) { const int t = t0 - 3 + rr; const v4u w = rraw[p];
                    f32x4 lo = (f32x4){__builtin_bit_cast(float, w.x << 16), __builtin_bit_cast(float, w.x & 0xffff0000u), __builtin_bit_cast(float, w.y << 16), __builtin_bit_cast(float, w.y & 0xffff0000u)};
                    f32x4 hi = (f32x4){__builtin_bit_cast(float, w.z << 16), __builtin_bit_cast(float, w.z & 0xffff0000u), __builtin_bit_cast(float, w.w << 16), __builtin_bit_cast(float, w.w & 0xffff0000u)};
                    if (t < 0 && samp) { const float* sp = a.in[I_SRGC] + (size_t)(b * 3 + 3 + t) * 2048 + 128 * n + c8; lo = *(const f32x4*)sp; hi = *(const f32x4*)(sp + 4); }
                    *(LAS f32x4*)(recf + rr * 132 + c8) = lo; *(LAS f32x4*)(recf + rr * 132 + c8 + 4) = hi; } }
#pragma unroll
            for (int p = 0; p < 2; ++p) *(LAS v4u*)(ytile + (32 * p + r) * 136 + c8) = yraw[p];
            LDS_WAIT(); __syncthreads();
            if (t0 + 64 < T) RG_LOAD(t0 + 64);
            { float x[19];
#pragma unroll
              for (int k = 0; k < 19; ++k) x[k] = recf[(16 * rg4 + k) * 132 + cc];
#pragma unroll
              for (int i = 0; i < 16; ++i) { const float xc = cbias + cw0 * x[i] + cw1 * x[i + 1] + cw2 * x[i + 2] + cw3 * x[i + 3];
                    xcf[(16 * rg4 + i) * 132 + cc] = xc; xcb[(16 * rg4 + i) * 136 + cc] = (unsigned short)(cvtpk(xc, 0.f) & 0xffffu); }
              if (t0 + 64 >= T && tid < 384) { const int k = tid >> 7; o_rgc[(size_t)(b * 3 + k) * 2048 + cch] = recf[(T - t0 + k) * 132 + cc]; } }
            LDS_WAIT(); __syncthreads();
#pragma unroll
            for (int rb = 0; rb < 4; ++rb) {
                if (t0 + 16 * rb < T) {
                    f32x4 accR = {0.f, 0.f, 0.f, 0.f}, accI = accR;
#pragma unroll
                    for (int ks = 0; ks < 4; ++ks) { const bf16x8 af = *(const LAS bf16x8*)(xcb + (16 * rb + col) * 136 + 32 * ks + 8 * quad);
                        accR = __builtin_amdgcn_mfma_f32_16x16x32_bf16(af, Br[ks], accR, 0, 0, 0); accI = __builtin_amdgcn_mfma_f32_16x16x32_bf16(af, Bi[ks], accI, 0, 0, 0); }
                    float av[4], bv[4]; float As = 1.f, Bs = 0.f;
#pragma unroll
                    for (int j = 0; j < 4; ++j) { const int t = 16 * rb + 4 * quad + j; const float xc = xcf[t * 132 + 16 * wid + col];
                        const float rg = sigmoidf_(accR[j] + gbr), ig = sigmoidf_(accI[j] + gbi), la = -sp8 * rg, aa = __builtin_amdgcn_exp2f(la * 1.4426950409f), x2 = 2.f * la;
                        const float om = (x2 > -0.02f) ? -x2 * (1.f + x2 * (0.5f + x2 * (0.16666667f + x2 * 0.041666668f))) : 1.f - aa * aa;
                        av[j] = aa; bv[j] = __builtin_sqrtf(om) * ig * xc; Bs = aa * Bs + bv[j]; As = aa * As; }
                    const float A0 = __shfl(As, col), B0 = __shfl(Bs, col), A1 = __shfl(As, col + 16), B1 = __shfl(Bs, col + 16), A2 = __shfl(As, col + 32), B2 = __shfl(Bs, col + 32), A3 = __shfl(As, col + 48), B3 = __shfl(Bs, col + 48);
                    const float h1 = A0 * hcar + B0, h2 = A1 * h1 + B1, h3 = A2 * h2 + B2, h4 = A3 * h3 + B3;
                    float hs = quad == 0 ? hcar : (quad == 1 ? h1 : (quad == 2 ? h2 : h3)); hcar = h4;
#pragma unroll
                    for (int j = 0; j < 4; ++j) { const int t = 16 * rb + 4 * quad + j; hs = av[j] * hs + bv[j];
                        const float y = bf2f(ytile[t * 136 + 16 * wid + col]);
                        hyt[t * 136 + 16 * wid + col] = (unsigned short)(cvtpk(hs * y, 0.f) & 0xffffu); }
                    if (t0 + 16 * (rb + 1) == T && quad == 0) o_rgh[(size_t)b * 2048 + ch] = hcar;
                }
            }
            LDS_WAIT(); __syncthreads();
#pragma unroll
            for (int p = 0; p < 2; ++p) { const int rr = 32 * p + r; if (t0 + rr < T) *(v4u*)(HY + (size_t)(row0 + t0 + rr) * DM + 128 * n + c8) = *(const LAS v4u*)(hyt + rr * 136 + c8); }
        }
        LDS_WAIT(); __syncthreads();
#undef RG_LOAD
    }
}

__device__ __forceinline__ void ffn_fixup(const Ctx& F, const Args& a, int layer) {
    const float* UE = (const float*)(F.ws + WS_UE); bf16* H = (bf16*)(F.ws + WS_H);
    const float* cw = a.in[I_FFNCW] + (size_t)layer * 3 * NUP; const float* cb = a.in[I_FFNCB] + (size_t)layer * NUP;
    const int tid = opaque_tid();
    const long gt = (long)F.vcu * 512 + tid, NT_ = (long)F.G * 512;
    constexpr int FG = DFF / 4;
    for (long it = gt; it < (long)NCB * FG; it += NT_) {
        const int cbi = (int)(it / FG), j = (int)(it % FG) * 4;
        const bool samp = cbi >= 512; const int rowA = samp ? MP + (cbi - 512) * 32 : cbi * 64;
        f32x4 u0[2], u1[2], hm2[2], hm1[2];
#pragma unroll
        for (int bj = 0; bj < 2; ++bj) { const int c = j + bj * DFF;
            u0[bj] = *(const f32x4*)(UE + ((size_t)cbi * 4 + 0) * NUP + c); u1[bj] = *(const f32x4*)(UE + ((size_t)cbi * 4 + 1) * NUP + c);
            if (samp) { const float* st = a.in[I_SFFN] + ((size_t)(layer * 16 + (cbi - 512)) * 2) * NUP + c; hm2[bj] = *(const f32x4*)st; hm1[bj] = *(const f32x4*)(st + NUP); }
            else if ((cbi & 31) == 0) { hm2[bj] = (f32x4){0.f, 0.f, 0.f, 0.f}; hm1[bj] = hm2[bj]; }
            else { hm2[bj] = *(const f32x4*)(UE + ((size_t)(cbi - 1) * 4 + 2) * NUP + c); hm1[bj] = *(const f32x4*)(UE + ((size_t)(cbi - 1) * 4 + 3) * NUP + c); } }
        f32x4 c0[2], c1[2];
#pragma unroll
        for (int bj = 0; bj < 2; ++bj) { const int c = j + bj * DFF; const f32x4 w0 = *(const f32x4*)(cw + c), w1 = *(const f32x4*)(cw + NUP + c), w2 = *(const f32x4*)(cw + 2 * NUP + c), bb = *(const f32x4*)(cb + c);
            c0[bj] = bb + w0 * hm2[bj] + w1 * hm1[bj] + w2 * u0[bj]; c1[bj] = bb + w0 * hm1[bj] + w1 * u0[bj] + w2 * u1[bj]; }
        v2u o0, o1; float h0[4], h1[4];
#pragma unroll
        for (int i = 0; i < 4; ++i) { h0[i] = gelu_tanh(c0[0][i]) * c0[1][i]; h1[i] = gelu_tanh(c1[0][i]) * c1[1][i]; }
        o0.x = cvtpk(h0[0], h0[1]); o0.y = cvtpk(h0[2], h0[3]); o1.x = cvtpk(h1[0], h1[1]); o1.y = cvtpk(h1[2], h1[3]);
        *(v2u*)(H + (size_t)rowA * DFF + j) = o0; *(v2u*)(H + (size_t)(rowA + 1) * DFF + j) = o1;
    }
    constexpr int NV = NUP / 4;
    for (long it = gt; it < (long)32 * 2 * NV; it += NT_) {
        const int sq = (int)(it / (2 * NV)), r = (int)((it / NV) & 1), c = (int)(it % NV) * 4;
        const bool samp = sq >= 16; const int cbi = samp ? 512 + (sq - 16) : 32 * sq + 31;
        float* o = F.out + (samp ? O_FFN_S : O_FFN_P) + ((size_t)(layer * 16 + (samp ? sq - 16 : sq)) * 2 + r) * NUP + c;
        *(f32x4*)o = *(const f32x4*)(UE + ((size_t)cbi * 4 + 2 + r) * NUP + c);
    }
}

__device__ __forceinline__ void resid_finish(const Ctx& F, const float* baseS, int f, float* ssout) {
    const int tid = opaque_tid(), lane = tid & 63, wave = __builtin_amdgcn_readfirstlane(tid >> 6);
    const int gw = F.vcu * NWAVES + wave, NGW = F.G * NWAVES;
    const float* slab = (const float*)(F.ws + WS_SLAB); bf16* XB = (bf16*)(F.ws + WS_XB);
    for (int r = gw; r < MS; r += NGW) {
        f32x4 v[8];
#pragma unroll
        for (int j = 0; j < 8; ++j) v[j] = *((const GAS f32x4*)(baseS + (size_t)r * DM) + lane + 64 * j);
        for (int ks = 0; ks < f; ++ks) { const GAS f32x4* sp = (const GAS f32x4*)(slab + ((size_t)ks * MS + r) * DM) + lane;
#pragma unroll
            for (int j = 0; j < 8; ++j) v[j] += sp[64 * j]; }
        float q = 0.f;
        GAS f32x4* xo = (GAS f32x4*)(F.out + (size_t)(MP + r) * DM) + lane; GAS v2u* bo = (GAS v2u*)(XB + (size_t)(MP + r) * DM) + lane;
#pragma unroll
        for (int j = 0; j < 8; ++j) { xo[64 * j] = v[j]; v2u w; w.x = cvtpk(v[j][0], v[j][1]); w.y = cvtpk(v[j][2], v[j][3]); bo[64 * j] = w;
            q += (v[j][0] * v[j][0] + v[j][1] * v[j][1]) + (v[j][2] * v[j][2] + v[j][3] * v[j][3]); }
        q = wave_sum(q);
        if (lane == 0) ssout[RS_OFF + MP + r] = __builtin_amdgcn_rsqf(q * (1.0f / DM) + EPS);
    }
    for (long row = (long)(F.G - 1 - F.vcu) * 512 + tid; row < MP; row += (long)F.G * 512) {
        const GAS f32x4* p = (const GAS f32x4*)(ssout + (size_t)row * 32); f32x4 a[8];
#pragma unroll
        for (int j = 0; j < 8; ++j) a[j] = p[j];
        float sq = 0.f;
#pragma unroll
        for (int j = 0; j < 8; ++j) sq += (a[j][0] + a[j][1]) + (a[j][2] + a[j][3]);
        ssout[RS_OFF + row] = __builtin_amdgcn_rsqf(sq * (1.0f / DM) + EPS);
    }
}

__device__ __forceinline__ void final_norm(const Ctx& F, const Args& a, const float* ss) {
    const int tid = opaque_tid(), lane = tid & 63, wave = __builtin_amdgcn_readfirstlane(tid >> 6);
    const int gw = F.vcu * NWAVES + wave, NGW = F.G * NWAVES;
    const GAS f32x4* gv = (const GAS f32x4*)a.in[I_FINNORM] + lane;
    f32x4 g[8], v[8]; float rs = 0.f;
#pragma unroll
    for (int j = 0; j < 8; ++j) { g[j] = gv[64 * j]; v[j] = (f32x4){0.f, 0.f, 0.f, 0.f}; }
    int m = gw;
    if (m < MT) { rs = ss[RS_OFF + (MT - 1 - m)]; const GAS f32x4* xv = (const GAS f32x4*)(F.out + (size_t)(MT - 1 - m) * DM) + lane;
#pragma unroll
        for (int j = 0; j < 8; ++j) v[j] = xv[64 * j]; }
    while (m < MT) {
        const int mn = m + NGW; f32x4 vn[8]; float rsn = 0.f;
#pragma unroll
        for (int j = 0; j < 8; ++j) vn[j] = (f32x4){0.f, 0.f, 0.f, 0.f};
        if (mn < MT) { rsn = ss[RS_OFF + (MT - 1 - mn)]; const GAS f32x4* xn = (const GAS f32x4*)(F.out + (size_t)(MT - 1 - mn) * DM) + lane;
#pragma unroll
            for (int j = 0; j < 8; ++j) vn[j] = xn[64 * j]; }
        asm volatile("" ::: "memory");
        GAS f32x4* xo = (GAS f32x4*)(F.out + (size_t)(MT - 1 - m) * DM) + lane;
#pragma unroll
        for (int j = 0; j < 8; ++j) xo[64 * j] = v[j] * rs * g[j];
#pragma unroll
        for (int j = 0; j < 8; ++j) v[j] = vn[j];
        rs = rsn; m = mn;
    }
}

namespace att {
constexpr int QBLK = 32, KVBLK = 64, QB = 256, PITCH = DM;
constexpr int SHM_V = 16384, SHM_K = 16384, A_V = 0, A_K = 32768, A_WS = 65536;
constexpr float SCALE = 0.08838834764831845f, THR = 8.f, C2 = 1.4426950408889634f * SCALE;
#define KSWZ(row, colB) ((row) * 256 + ((colB) ^ (((row) & 7) << 4)))
#define SBAR() __builtin_amdgcn_sched_barrier(0)
__device__ __forceinline__ int v_st(int k, int c) { const int kk = (k & ~0xC) | ((k & 4) << 1) | ((k & 8) >> 1); return ((kk >> 3) * 4 + (c >> 5)) * 512 + ((kk & 7) * 32 + (c & 31)) * 2; }
__device__ __forceinline__ int v_rd_base(int lane) { return ((lane & 3) << 3) | (((lane >> 2) & 3) << 6) | (((lane >> 4) & 1) << 5) | (((lane >> 5) & 1) << 8); }
constexpr int v_rd_off(int d0, int ks, int half) { return d0 * 512 + ks * 4096 + half * 2048; }
__device__ __forceinline__ int crow(int r, int hi) { return (r & 3) + 8 * (r >> 2) + 4 * hi; }
__device__ __forceinline__ void partialSM(f32x16& p0, f32x16& p1, float& m_reg, float& mn, float& alpha) {
    float pmax = p0[0];
#pragma unroll
    for (int r = 1; r < 16; ++r) pmax = fmaxf(pmax, p0[r]);
#pragma unroll
    for (int r = 0; r < 16; ++r) pmax = fmaxf(pmax, p1[r]);
    { auto rr = __builtin_amdgcn_permlane32_swap(__float_as_uint(pmax), __float_as_uint(pmax), false, false);
      pmax = fmaxf(__uint_as_float(rr[0]), __uint_as_float(rr[1])); }
    if (__builtin_expect(__all((pmax - m_reg) * SCALE <= THR), 1)) { mn = m_reg; alpha = 1.f; }
    else { mn = fmaxf(m_reg, pmax); alpha = __builtin_amdgcn_exp2f((m_reg - mn) * C2); m_reg = mn; }
    const float mnL = -mn * C2;
#pragma unroll
    for (int r = 0; r < 16; ++r) p0[r] = fmaf(p0[r], C2, mnL);
#pragma unroll
    for (int r = 0; r < 16; ++r) p1[r] = fmaf(p1[r], C2, mnL);
#pragma unroll
    for (int r = 0; r < 16; ++r) p0[r] = __builtin_amdgcn_exp2f(p0[r]);
}
__device__ __forceinline__ void finishSM(f32x16& p0, f32x16& p1, float alpha, float& l_reg, bf16x8& pa0, bf16x8& pa1, bf16x8& pa2, bf16x8& pa3) {
#pragma unroll
    for (int r = 0; r < 16; ++r) p1[r] = __builtin_amdgcn_exp2f(p1[r]);
    float ps = 0;
#pragma unroll
    for (int r = 0; r < 16; ++r) ps += p0[r];
#pragma unroll
    for (int r = 0; r < 16; ++r) ps += p1[r];
    { auto rr = __builtin_amdgcn_permlane32_swap(__float_as_uint(ps), __float_as_uint(ps), false, false);
      ps = __uint_as_float(rr[0]) + __uint_as_float(rr[1]); }
    l_reg = l_reg * alpha + ps;
#define PK4(P, B_, OUT) do { unsigned a0 = cvtpk(P[B_+0], P[B_+1]), a1 = cvtpk(P[B_+2], P[B_+3]);                          \
        unsigned b0 = cvtpk(P[B_+4], P[B_+5]), b1 = cvtpk(P[B_+6], P[B_+7]);                                             \
        auto r0 = __builtin_amdgcn_permlane32_swap(a0, b0, false, false); auto r1 = __builtin_amdgcn_permlane32_swap(a1, b1, false, false); \
        v4u w = {r0[0], r1[0], r0[1], r1[1]}; OUT = __builtin_bit_cast(bf16x8, w); } while (0)
    PK4(p0, 0, pa0); PK4(p0, 8, pa1); PK4(p1, 0, pa2); PK4(p1, 8, pa3);
#undef PK4
}
template <int KB>
__device__ __forceinline__ void qkt(f32x16& p0, f32x16& p1, const LAS unsigned char* K_lds, int r32, int hi, const bf16x8* qr, bool act) {
    if (!act) { const float NEG = -__builtin_inff();
#pragma unroll
        for (int r = 0; r < 16; ++r) { p0[r] = NEG; p1[r] = NEG; } return; }
    p0 = f32x16{}; p1 = f32x16{};
    const LAS unsigned char* kb[4];
#pragma unroll
    for (int dd = 0; dd < 4; ++dd) kb[dd] = K_lds + KB * SHM_K + KSWZ(r32, (dd * 16 + hi * 8) * 2);
#pragma unroll
    for (int d0 = 0; d0 < 8; ++d0) { const LAS unsigned char* a = kb[d0 & 3] + (d0 >> 2) * 128;
        bf16x8 b0 = *reinterpret_cast<const LAS bf16x8*>(a);
        bf16x8 b1 = *reinterpret_cast<const LAS bf16x8*>(a + 32 * 256);
        p0 = __builtin_amdgcn_mfma_f32_32x32x16_bf16(b0, qr[d0], p0, 0, 0, 0);
        p1 = __builtin_amdgcn_mfma_f32_32x32x16_bf16(b1, qr[d0], p1, 0, 0, 0); }
}
template <int VB>
__device__ __forceinline__ void pv_tile(f32x16* o, int vb0, bf16x8 pa0, bf16x8 pa1, bf16x8 pa2, bf16x8 pa3, bool act) {
    if (!act) return;
#define TRRD(dst, off) asm volatile("ds_read_b64_tr_b16 %0, %1 offset:%2" : "=&v"(dst) : "v"(vb0), "i"(off) : "memory")
#define PV_D0(d0) do { s16x4 l0, l1, l2, l3, h0, h1, h2, h3; constexpr int b_ = VB * SHM_V + v_rd_off(d0, 0, 0); \
        TRRD(l0, b_); TRRD(h0, b_ + 2048); TRRD(l1, b_ + 4096); TRRD(h1, b_ + 6144); TRRD(l2, b_ + 8192); TRRD(h2, b_ + 10240); TRRD(l3, b_ + 12288); TRRD(h3, b_ + 14336); \
        asm volatile("s_waitcnt lgkmcnt(0)" ::: "memory"); SBAR();   \
        o[d0] = __builtin_amdgcn_mfma_f32_32x32x16_bf16(pa0, (bf16x8){l0[0], l0[1], l0[2], l0[3], h0[0], h0[1], h0[2], h0[3]}, o[d0], 0, 0, 0);   \
        o[d0] = __builtin_amdgcn_mfma_f32_32x32x16_bf16(pa1, (bf16x8){l1[0], l1[1], l1[2], l1[3], h1[0], h1[1], h1[2], h1[3]}, o[d0], 0, 0, 0);   \
        o[d0] = __builtin_amdgcn_mfma_f32_32x32x16_bf16(pa2, (bf16x8){l2[0], l2[1], l2[2], l2[3], h2[0], h2[1], h2[2], h2[3]}, o[d0], 0, 0, 0);   \
        o[d0] = __builtin_amdgcn_mfma_f32_32x32x16_bf16(pa3, (bf16x8){l3[0], l3[1], l3[2], l3[3], h3[0], h3[1], h3[2], h3[3]}, o[d0], 0, 0, 0); } while (0)
    PV_D0(0); PV_D0(1); PV_D0(2); PV_D0(3);
#undef PV_D0
#undef TRRD
}
struct BlockRef { const bf16* Q; const bf16* K; const bf16* V; int P0, mode, orow, h; };
struct Seam { bf16x8 qr[8]; bf16x8 st_v0, st_v1, st_k0, st_k1; };
__device__ __forceinline__ GAS char* uni(const void* p) { const unsigned long long b = (unsigned long long)p; const unsigned lo = __builtin_amdgcn_readfirstlane((unsigned)b), hi = __builtin_amdgcn_readfirstlane((unsigned)(b >> 32)); return (GAS char*)(((unsigned long long)hi << 32) | lo); }
#define ROW(p, k0, rr) (uni((const char*)(p) + (size_t)((k0) + (rr)) * (PITCH * 2)) + loff)
#define VMW() asm volatile("s_waitcnt vmcnt(0)" ::: "memory")
#define VMWN(n) asm volatile("s_waitcnt vmcnt(%0)" :: "i"(n) : "memory")
#define LD8(p) (*(const GAS bf16x8*)(p))
#define SLOAD_H(Kp, Vp, k0) do { S.st_v0 = LD8(ROW(Vp, k0, 0)); S.st_v1 = LD8(ROW(Vp, k0, 32)); S.st_k0 = LD8(ROW(Kp, k0, 0)); S.st_k1 = LD8(ROW(Kp, k0, 32)); } while (0)
#define SWRITE_HK(bf) do { *(LAS bf16x8*)(K_lds + (bf) * SHM_K + kws) = S.st_k0; *(LAS bf16x8*)(K_lds + (bf) * SHM_K + kws + 32 * 256) = S.st_k1; } while (0)
#define SWRITE_HV(bf) do { *(LAS bf16x8*)(V_lds + (bf) * SHM_V + vst0) = S.st_v0; *(LAS bf16x8*)(V_lds + (bf) * SHM_V + vst1) = S.st_v1; } while (0)
#define SWRITE_H(bf) do { SWRITE_HV(bf); SWRITE_HK(bf); } while (0)
__device__ __forceinline__ void prime(const BlockRef& cur, LAS unsigned char* lds, Seam& S) {
    const int tid = opaque_tid(), wid = __builtin_amdgcn_readfirstlane(tid >> 6), lane = tid & 63, r32 = lane & 31, hi = lane >> 5;
    const int sr = tid >> 4, sc = (tid & 15) * 8, kws = KSWZ(sr, sc * 2); LAS unsigned char* K_lds = lds + A_K;
    const unsigned loff = (unsigned)(sr * PITCH + sc) * 2u, qoff = (unsigned)(r32 * PITCH + hi * 8) * 2u;
#pragma unroll
    for (int d0 = 0; d0 < 8; ++d0) S.qr[d0] = LD8(uni(cur.Q + (size_t)(wid * QBLK) * PITCH) + qoff + d0 * 32);
    SLOAD_H(cur.K, cur.V, 0); VMW(); SWRITE_HK(0);
    __syncthreads();
}
__device__ __forceinline__ void block(const BlockRef& cur, const BlockRef& nxt, LAS unsigned char* lds, Seam& S, float lam, const float* subln, float* stash, bf16* OB) {
    const int tid = opaque_tid(), wid = __builtin_amdgcn_readfirstlane(tid >> 6), lane = tid & 63, r32 = lane & 31, hi = lane >> 5;
    const int NT = cur.P0 / KVBLK + 4;
    const int qe = (cur.P0 + wid * QBLK) | 63;
    LAS unsigned char* V_lds = lds + A_V; LAS unsigned char* K_lds = lds + A_K;
    LAS float* ws = (LAS float*)(lds + A_WS) + wid * 64; LAS float* li_l = ws; LAS float* al_l = ws + 32;
    float m_reg = -1e30f, l_reg = 0; f32x16 o[4] = {};
    const int sr = tid >> 4, sc = (tid & 15) * 8, vst0 = v_st(sr, sc), vst1 = v_st(32 + sr, sc), kws = KSWZ(sr, sc * 2);
    const unsigned loff = (unsigned)(sr * PITCH + sc) * 2u, qoff = (unsigned)(r32 * PITCH + hi * 8) * 2u;
    const int vb0 = (int)(unsigned)(uintptr_t)V_lds + v_rd_base(lane);
    const bf16* Kh = cur.K; const bf16* Vh = cur.V;
#define RESC(a) do { if (__any((a) < 1.f)) { if (hi == 0) al_l[r32] = (a); asm volatile("s_waitcnt lgkmcnt(0)" ::: "memory");              \
                     for (int d_ = 0; d_ < 4; ++d_) for (int r = 0; r < 16; ++r) o[d_][r] *= al_l[crow(r, hi)]; } } while (0)
#define KBASE(t) ((t) * KVBLK)
#define ACT(t) (KBASE(t) <= qe)
#define SEAM_K0() do { VMWN(8); SWRITE_HK(0); SBAR(); } while (0)
    f32x16 pA0, pA1, pB0, pB1; float mnA, mnB, alA, alB; bf16x8 pa0, pa1, pa2, pa3;
    SWRITE_HV(0); SBAR();
    if (NT > 1) SLOAD_H(Kh, Vh, KBASE(1));
    SBAR(); qkt<0>(pA0, pA1, K_lds, r32, hi, S.qr, ACT(0));
    partialSM(pA0, pA1, m_reg, mnA, alA);
    if (NT > 1) { VMW(); SWRITE_H(1); }
    __syncthreads();
#define HALF_STEP(PX0, PX1, mnX, alX, PY0, PY1, alY, t, KB, VB, SB) do {                                                      \
        SBAR(); qkt<KB>(PX0, PX1, K_lds, r32, hi, S.qr, ACT(t));                                             \
        finishSM(PY0, PY1, alY, l_reg, pa0, pa1, pa2, pa3); SBAR();                                                           \
        if ((t) + 1 < NT) { SLOAD_H(Kh, Vh, KBASE((t) + 1)); SBAR(); }                                               \
        pv_tile<VB>(o, vb0, pa0, pa1, pa2, pa3, ACT((t) - 1)); partialSM(PX0, PX1, m_reg, mnX, alX);                                        \
        __syncthreads();                                                                                                      \
        if ((t) + 1 < NT) { VMW(); SWRITE_H(SB); }                                                                          \
        RESC(alX); __syncthreads(); } while (0)
    for (int t = 1; t + 1 < NT; t += 2) {
        HALF_STEP(pB0, pB1, mnB, alB, pA0, pA1, alA, t, 1, 0, 0);
        HALF_STEP(pA0, pA1, mnA, alA, pB0, pB1, alB, t + 1, 0, 1, 1);
    }
    SBAR(); qkt<1>(pB0, pB1, K_lds, r32, hi, S.qr, ACT(NT - 1)); SBAR();
    SLOAD_H(nxt.K, nxt.V, 0); SBAR();
#pragma unroll
    for (int d0 = 0; d0 < 8; ++d0) S.qr[d0] = LD8(uni(nxt.Q + (size_t)(wid * QBLK) * PITCH) + qoff + d0 * 32);
    SBAR();
    finishSM(pA0, pA1, alA, l_reg, pa0, pa1, pa2, pa3); SBAR();
    pv_tile<0>(o, vb0, pa0, pa1, pa2, pa3, ACT(NT - 2));
    partialSM(pB0, pB1, m_reg, mnB, alB); __syncthreads(); RESC(alB);
    finishSM(pB0, pB1, alB, l_reg, pa0, pa1, pa2, pa3); SBAR(); pv_tile<1>(o, vb0, pa0, pa1, pa2, pa3, ACT(NT - 1));
    SBAR(); SEAM_K0();
    if (hi == 0) li_l[r32] = l_reg; asm volatile("s_waitcnt lgkmcnt(0)" ::: "memory");
    float rli[16];
#pragma unroll
    for (int r = 0; r < 16; ++r) rli[r] = __builtin_amdgcn_rcpf(li_l[crow(r, hi)]);
    GAS char* stb = uni(stash + ((size_t)(blockIdx.x * NWAVES + wid) * ST_PER_LANE) * 64);
    const unsigned sl = (unsigned)lane * 4u;
#define ST_AT(idx) (*(GAS float*)(stb + (size_t)(idx) * 256 + sl))
#define MFENCE() asm volatile("" ::: "memory")
    const int mode = cur.mode;
    if ((mode & 1) == 0) {
#pragma unroll
        for (int d0 = 0; d0 < 4; ++d0) {
#pragma unroll
            for (int r = 0; r < 16; ++r) ST_AT(d0 * 16 + r) = o[d0][r] * rli[r];
            MFENCE(); }
    } else if (mode == 1) {
        float ssp[16];
#pragma unroll
        for (int r = 0; r < 16; ++r) ssp[r] = 0.f;
#pragma unroll
        for (int d0 = 0; d0 < 4; ++d0) { float t2[16];
#pragma unroll
            for (int r = 0; r < 16; ++r) t2[r] = ST_AT(d0 * 16 + r);
#pragma unroll
            for (int r = 0; r < 16; ++r) { const float x = o[d0][r] * rli[r] - lam * t2[r]; ST_AT(64 + d0 * 16 + r) = x; ssp[r] += x * x; }
            MFENCE(); }
#pragma unroll
        for (int r = 0; r < 16; ++r) ST_AT(128 + r) = ssp[r];
    } else {
        float ssp[16];
#pragma unroll
        for (int r = 0; r < 16; ++r) ssp[r] = ST_AT(128 + r);
#pragma unroll
        for (int d0 = 0; d0 < 4; ++d0) { float t2[16];
#pragma unroll
            for (int r = 0; r < 16; ++r) t2[r] = ST_AT(d0 * 16 + r);
#pragma unroll
            for (int r = 0; r < 16; ++r) { const float x = o[d0][r] * rli[r] - lam * t2[r]; o[d0][r] = x; ssp[r] += x * x; }
            MFENCE(); }
#pragma unroll
        for (int r = 0; r < 16; ++r) { float q = ssp[r]; q += __shfl_xor(q, 1); q += __shfl_xor(q, 2); q += __shfl_xor(q, 4); q += __shfl_xor(q, 8); q += __shfl_xor(q, 16);
            ssp[r] = __builtin_amdgcn_rsqf(q * (1.0f / 256.0f) + EPS) * (1.0f - LAMBDA_INIT); }
        GAS char* Owb = uni(OB + (size_t)(cur.orow + wid * QBLK) * DM + cur.h * 256);
        const unsigned ol = (unsigned)(4 * hi * DM + r32) * 2u;
#pragma unroll
        for (int d0 = 0; d0 < 4; ++d0) { const float g1 = subln[128 + d0 * 32 + r32], g0 = subln[d0 * 32 + r32];
#pragma unroll
            for (int r = 0; r < 16; ++r) { const unsigned ro = ol + (unsigned)(((r & 3) + 8 * (r >> 2)) * DM + d0 * 32) * 2u;
                const float v1 = o[d0][r] * ssp[r] * g1, v0 = ST_AT(64 + d0 * 16 + r) * ssp[r] * g0;
                const float v1n = __shfl_xor(v1, 1), v0n = __shfl_xor(v0, 1);
                if ((r32 & 1) == 0) { *(GAS unsigned*)(Owb + ro + 256) = cvtpk(v1, v1n); *(GAS unsigned*)(Owb + ro) = cvtpk(v0, v0n); }
                if ((r & 3) == 3) MFENCE(); } }
    }
#undef ST_AT
#undef MFENCE
    __syncthreads();
#undef RESC
#undef KBASE
#undef ACT
#undef SEAM_K0
#undef HALF_STEP
}
#undef SLOAD_H
#undef SWRITE_HK
#undef SWRITE_HV
#undef SWRITE_H

__device__ __forceinline__ BlockRef decode(int k, int c, int G, const bf16* Qb, const bf16* Kb, const bf16* Vb) {
    const int L = c + (k >> 3) * G, sub = k & 7, pass = sub >> 2, run = sub & 3, bh = L >> 2, x = L & 3, qb = pass ? 7 - x : x, b = bh >> 3, h = bh & 7;
    const int mapj = (run & 1) ? 0 : 1, vh = run >> 1, hv = 2 * h + mapj;
    BlockRef r; r.Q = Qb + (size_t)(b * SEQ + qb * QB) * DM + hv * 128; r.K = Kb + (size_t)(b * SEQ) * DM + hv * 128; r.V = Vb + (size_t)(b * SEQ) * DM + h * 256 + vh * 128;
    r.P0 = qb * QB; r.mode = run; r.orow = b * SEQ + qb * QB; r.h = h; return r;
}

constexpr int B2_V = 0, B2_K = 32768, B2_Q = 69632;
static_assert(B2_Q + 8 * 32 * 136 * 2 <= LDSCTL_OFF && A_WS + 2048 <= B2_Q, "block2 LDS map");
__device__ __forceinline__ void block2(const BlockRef& cur, LAS unsigned char* lds, float lam, const float* subln, float* stash, bf16* OB) {
    const int tid = opaque_tid(), wid = __builtin_amdgcn_readfirstlane(tid >> 6), lane = tid & 63, r32 = lane & 31, hi = lane >> 5;
    const int NT = cur.P0 / 32 + 8;
    const int qe = (cur.P0 + wid * QBLK) | 63;
    LAS unsigned char* V_lds = lds + B2_V; LAS unsigned char* K_lds = lds + B2_K;
    LAS float* ws = (LAS float*)(lds + A_WS) + wid * 64; LAS float* li_l = ws; LAS float* al_l = ws + 32;
    const int sr = tid >> 4, sc = (tid & 15) * 8, vst = v_st(sr, sc), kws = KSWZ(sr, sc * 2);
    const unsigned loff = (unsigned)(sr * PITCH + sc) * 2u;
    const int vb0 = (int)(unsigned)(uintptr_t)V_lds + v_rd_base(lane);
    int kb[4];
#pragma unroll
    for (int dd = 0; dd < 4; ++dd) kb[dd] = KSWZ(r32, (dd * 16 + hi * 8) * 2);
    LAS unsigned short* QL = (LAS unsigned short*)(lds + B2_Q) + wid * (32 * 136);
    { const GAS char* qg = uni(cur.Q + (size_t)(wid * QBLK) * PITCH);
#pragma unroll
      for (int p = 0; p < 8; ++p) { const int id = lane + 64 * p, row = id >> 4, ch = id & 15;
          *(LAS bf16x8*)(QL + row * 136 + ch * 8) = LD8(qg + (size_t)row * (PITCH * 2) + ch * 16); } }
    const LAS unsigned short* qrow = QL + r32 * 136 + hi * 8;
    float m_reg = -1e30f, l_reg = 0.f; f32x16 o0[4] = {}, o1[4] = {};
    unsigned gK, gV;
    { const int o = wid * 1024 + lane * 16;
      { const int row = o >> 8, cb = (o & 255) ^ ((row & 7) << 4); gK = (unsigned)(row * (PITCH * 2) + cb); }
      { const int sub = o >> 9, kh = sub >> 2, c5 = sub & 3, rem = (o & 511) >> 1, kk = kh * 8 + (rem >> 5), c = c5 * 32 + (rem & 31);
        const int k = (kk & ~0xC) | ((kk & 4) << 1) | ((kk & 8) >> 1); gV = (unsigned)(k * (PITCH * 2) + c * 2); } }
#define B2_LOAD(t, bf) do { const GAS char* kt_ = uni((const char*)cur.K + (size_t)(32 * (t)) * (PITCH * 2)); const GAS char* vt_ = uni((const char*)cur.V + (size_t)(32 * (t)) * (PITCH * 2)); \
        __builtin_amdgcn_global_load_lds((const GAS unsigned*)(kt_ + gK), (LAS unsigned*)(K_lds + (bf) * 8192 + wid * 1024), 16, 0, 0); \
        __builtin_amdgcn_global_load_lds((const GAS unsigned*)(vt_ + gV), (LAS unsigned*)(V_lds + (bf) * 16384 + wid * 1024), 16, 0, 0); \
        __builtin_amdgcn_global_load_lds((const GAS unsigned*)(vt_ + gV + 256), (LAS unsigned*)(V_lds + (bf) * 16384 + 8192 + wid * 1024), 16, 0, 0); } while (0)
#define B2_TRRD(dst, off) asm volatile("ds_read_b64_tr_b16 %0, %1 offset:%2" : "=&v"(dst) : "v"(vb0), "i"(off) : "memory")
#define B2_RD16(l0, h0, l1, h1, BF, HALF) do { constexpr int b_ = (BF) * 16384 + (HALF) * 8192; \
        B2_TRRD(l0[0], b_); B2_TRRD(h0[0], b_ + 2048); B2_TRRD(l1[0], b_ + 4096); B2_TRRD(h1[0], b_ + 6144); \
        B2_TRRD(l0[1], b_ + 512); B2_TRRD(h0[1], b_ + 512 + 2048); B2_TRRD(l1[1], b_ + 512 + 4096); B2_TRRD(h1[1], b_ + 512 + 6144); \
        B2_TRRD(l0[2], b_ + 1024); B2_TRRD(h0[2], b_ + 1024 + 2048); B2_TRRD(l1[2], b_ + 1024 + 4096); B2_TRRD(h1[2], b_ + 1024 + 6144); \
        B2_TRRD(l0[3], b_ + 1536); B2_TRRD(h0[3], b_ + 1536 + 2048); B2_TRRD(l1[3], b_ + 1536 + 4096); B2_TRRD(h1[3], b_ + 1536 + 6144); } while (0)
#define B2_MM8(oo, l0, h0, l1, h1) do { _Pragma("unroll") for (int d0 = 0; d0 < 4; ++d0) { \
        oo[d0] = __builtin_amdgcn_mfma_f32_32x32x16_bf16(pa0, (bf16x8){l0[d0][0], l0[d0][1], l0[d0][2], l0[d0][3], h0[d0][0], h0[d0][1], h0[d0][2], h0[d0][3]}, oo[d0], 0, 0, 0); \
        oo[d0] = __builtin_amdgcn_mfma_f32_32x32x16_bf16(pa1, (bf16x8){l1[d0][0], l1[d0][1], l1[d0][2], l1[d0][3], h1[d0][0], h1[d0][1], h1[d0][2], h1[d0][3]}, oo[d0], 0, 0, 0); } } while (0)
#define B2_STEP(t, BF) do { \
        if ((t) + 1 < NT) B2_LOAD((t) + 1, (BF) ^ 1);       \
        SBAR(); \
        if (32 * (t) <= qe) { \
            f32x16 p0 = {}; \
            _Pragma("unroll") for (int d0 = 0; d0 < 8; ++d0) { const bf16x8 b0 = *(const LAS bf16x8*)(K_lds + (BF) * 8192 + kb[d0 & 3] + (d0 >> 2) * 128); \
                p0 = __builtin_amdgcn_mfma_f32_32x32x16_bf16(b0, *(const LAS bf16x8*)(qrow + d0 * 16), p0, 0, 0, 0); } \
            float pmax = p0[0]; \
            _Pragma("unroll") for (int r = 1; r < 16; ++r) pmax = fmaxf(pmax, p0[r]); \
            { auto rr = __builtin_amdgcn_permlane32_swap(__float_as_uint(pmax), __float_as_uint(pmax), false, false); pmax = fmaxf(__uint_as_float(rr[0]), __uint_as_float(rr[1])); } \
            float alpha = 1.f; \
            if (!__all((pmax - m_reg) * SCALE <= THR)) { const float mn = fmaxf(m_reg, pmax); alpha = __builtin_amdgcn_exp2f((m_reg - mn) * C2); m_reg = mn; } \
            const float mnL = -m_reg * C2; float ps = 0.f; \
            _Pragma("unroll") for (int r = 0; r < 16; ++r) { p0[r] = __builtin_amdgcn_exp2f(fmaf(p0[r], C2, mnL)); ps += p0[r]; } \
            { auto rr = __builtin_amdgcn_permlane32_swap(__float_as_uint(ps), __float_as_uint(ps), false, false); ps = __uint_as_float(rr[0]) + __uint_as_float(rr[1]); } \
            l_reg = l_reg * alpha + ps; \
            bf16x8 pa0, pa1; \
            { const unsigned a0 = cvtpk(p0[0], p0[1]), a1 = cvtpk(p0[2], p0[3]), b0_ = cvtpk(p0[4], p0[5]), b1_ = cvtpk(p0[6], p0[7]); \
              auto r0 = __builtin_amdgcn_permlane32_swap(a0, b0_, false, false); auto r1 = __builtin_amdgcn_permlane32_swap(a1, b1_, false, false); \
              v4u w = {r0[0], r1[0], r0[1], r1[1]}; pa0 = __builtin_bit_cast(bf16x8, w); } \
            { const unsigned a0 = cvtpk(p0[8], p0[9]), a1 = cvtpk(p0[10], p0[11]), b0_ = cvtpk(p0[12], p0[13]), b1_ = cvtpk(p0[14], p0[15]); \
              auto r0 = __builtin_amdgcn_permlane32_swap(a0, b0_, false, false); auto r1 = __builtin_amdgcn_permlane32_swap(a1, b1_, false, false); \
              v4u w = {r0[0], r1[0], r0[1], r1[1]}; pa1 = __builtin_bit_cast(bf16x8, w); } \
            if (__any(alpha < 1.f)) { if (hi == 0) al_l[r32] = alpha; asm volatile("s_waitcnt lgkmcnt(0)" ::: "memory"); \
                _Pragma("unroll") for (int d_ = 0; d_ < 4; ++d_) _Pragma("unroll") for (int r = 0; r < 16; ++r) { const float f_ = al_l[crow(r, hi)]; o0[d_][r] *= f_; o1[d_][r] *= f_; } \
                asm volatile("s_waitcnt lgkmcnt(0)" ::: "memory"); } \
            SBAR(); \
            { s16x4 al0[4], ah0[4], al1[4], ah1[4], bl0[4], bh0[4], bl1[4], bh1[4]; \
              B2_RD16(al0, ah0, al1, ah1, BF, 0); asm volatile("s_waitcnt lgkmcnt(0)" ::: "memory"); SBAR(); \
              B2_RD16(bl0, bh0, bl1, bh1, BF, 1); SBAR();              \
              B2_MM8(o0, al0, ah0, al1, ah1); SBAR(); \
              asm volatile("s_waitcnt lgkmcnt(0)" ::: "memory"); SBAR(); \
              B2_MM8(o1, bl0, bh0, bl1, bh1); } \
        } \
        SBAR(); \
        VMW(); asm volatile("s_waitcnt lgkmcnt(0)" ::: "memory"); __builtin_amdgcn_s_barrier(); asm volatile("" ::: "memory"); } while (0)
    B2_LOAD(0, 0); VMW();
    __syncthreads();
    for (int t = 0; t < NT; t += 2) { B2_STEP(t, 0); B2_STEP(t + 1, 1); }
    if (hi == 0) li_l[r32] = l_reg; asm volatile("s_waitcnt lgkmcnt(0)" ::: "memory");
    float rli[16];
#pragma unroll
    for (int r = 0; r < 16; ++r) rli[r] = __builtin_amdgcn_rcpf(li_l[crow(r, hi)]);
    GAS char* stb = uni(stash + ((size_t)(blockIdx.x * NWAVES + wid) * ST_PER_LANE) * 64);
    const unsigned sl = (unsigned)lane * 4u;
#define ST_AT(idx) (*(GAS float*)(stb + (size_t)(idx) * 256 + sl))
#define B2_FENCE() do { asm volatile("" ::: "memory"); __builtin_amdgcn_sched_barrier(0); } while (0)
    if (cur.mode == 0) {
#pragma unroll
        for (int d0 = 0; d0 < 4; ++d0) {
#pragma unroll
            for (int r = 0; r < 16; ++r) ST_AT(d0 * 16 + r) = o0[d0][r] * rli[r];
            B2_FENCE();
#pragma unroll
            for (int r = 0; r < 16; ++r) ST_AT(64 + d0 * 16 + r) = o1[d0][r] * rli[r];
            B2_FENCE(); }
    } else {
        float ssp[16];
#pragma unroll
        for (int r = 0; r < 16; ++r) ssp[r] = 0.f;
#pragma unroll
        for (int d0 = 0; d0 < 4; ++d0) {
            { float t2[16];
#pragma unroll
              for (int r = 0; r < 16; ++r) t2[r] = ST_AT(d0 * 16 + r);
#pragma unroll
              for (int r = 0; r < 16; ++r) { const float x = o0[d0][r] * rli[r] - lam * t2[r]; ST_AT(d0 * 16 + r) = x; ssp[r] += x * x; } }
            B2_FENCE();
            { float t3[16];
#pragma unroll
              for (int r = 0; r < 16; ++r) t3[r] = ST_AT(64 + d0 * 16 + r);
#pragma unroll
              for (int r = 0; r < 16; ++r) { const float y = o1[d0][r] * rli[r] - lam * t3[r]; ST_AT(64 + d0 * 16 + r) = y; ssp[r] += y * y; } }
            B2_FENCE(); }
#pragma unroll
        for (int r = 0; r < 16; ++r) { float q = ssp[r]; q += __shfl_xor(q, 1); q += __shfl_xor(q, 2); q += __shfl_xor(q, 4); q += __shfl_xor(q, 8); q += __shfl_xor(q, 16);
            ssp[r] = __builtin_amdgcn_rsqf(q * (1.0f / 256.0f) + EPS) * (1.0f - LAMBDA_INIT); }
        B2_FENCE();
        GAS char* Owb = uni(OB + (size_t)(cur.orow + wid * QBLK) * DM + cur.h * 256);
        const unsigned ol = (unsigned)(4 * hi * DM + r32) * 2u;
#pragma unroll
        for (int half = 0; half < 2; ++half)
#pragma unroll
            for (int d0 = 0; d0 < 4; ++d0) { const float g = subln[half * 128 + d0 * 32 + r32]; float xv[16];
#pragma unroll
                for (int r = 0; r < 16; ++r) xv[r] = ST_AT(half * 64 + d0 * 16 + r);
#pragma unroll
                for (int r = 0; r < 16; ++r) { const unsigned ro = ol + (unsigned)(((r & 3) + 8 * (r >> 2)) * DM + half * 128 + d0 * 32) * 2u;
                    const float v = xv[r] * ssp[r] * g; const float vn = __shfl_xor(v, 1);
                    if ((r32 & 1) == 0) *(GAS unsigned*)(Owb + ro) = cvtpk(v, vn); }
                B2_FENCE(); }
    }
#undef B2_FENCE
#undef ST_AT
    __syncthreads();
#undef B2_LOAD
#undef B2_TRRD
#undef B2_RD16
#undef B2_MM8
#undef B2_STEP
}
__device__ __forceinline__ BlockRef decode2(int k, int c, int G, const bf16* Qb, const bf16* Kb, const bf16* Vb) {
    const int L = c + (k >> 2) * G, sub = k & 3, pass = sub >> 1, m1 = sub & 1, bh = L >> 2, x = L & 3, qb = pass ? 7 - x : x, b = bh >> 3, h = bh & 7;
    const int hv = 2 * h + (m1 ? 0 : 1);
    BlockRef r; r.Q = Qb + (size_t)(b * SEQ + qb * QB) * DM + hv * 128; r.K = Kb + (size_t)(b * SEQ) * DM + hv * 128; r.V = Vb + (size_t)(b * SEQ) * DM + h * 256;
    r.P0 = qb * QB; r.mode = m1; r.orow = b * SEQ + qb * QB; r.h = h; return r;
}

constexpr int SA_ML = 0, SA_FAC = 2048, SA_SSQ = 3072, SA_OBUF = 4096, SA_Q = SA_OBUF + 4 * 32 * 128 * 4;
__device__ __forceinline__ void sample_unit(LAS unsigned char* lds, int s, int h, const Args& a, const bf16* Qb, float* out, bf16* OB, float lam) {
    const int tid = opaque_tid(), wid = __builtin_amdgcn_readfirstlane(tid >> 6), lane = tid & 63, r32 = lane & 31, hi = lane >> 5;
    const int mj = wid >> 2, dh = (wid >> 1) & 1, ks = wid & 1, hv = 2 * h + mj;
    LAS float* ML = (LAS float*)(lds + SA_ML); LAS float* FAC = (LAS float*)(lds + SA_FAC); LAS float* SSQ = (LAS float*)(lds + SA_SSQ); LAS float* OBUF = (LAS float*)(lds + SA_OBUF);
    LAS unsigned short* QL = (LAS unsigned short*)(lds + SA_Q);
    { const int m2 = tid >> 8, row = (tid >> 3) & 31, ch = tid & 7;
#pragma unroll
      for (int p = 0; p < 2; ++p) { const int c8 = (ch + 8 * p) * 8;
          *(LAS v4u*)(QL + (m2 * 32 + row) * 136 + c8) = *(const GAS v4u*)((const GAS bf16*)Qb + (size_t)(MP + DECS * s + row) * DM + (2 * h + m2) * 128 + c8); } }
    LDS_WAIT(); __syncthreads();
    const LAS unsigned short* qrow = QL + (mj * 32 + r32) * 136 + hi * 8;
    float m_reg = -1e30f, l_reg = 0.f; f32x16 o[4] = {};
    const int ntile = ks ? 33 : 32;
    for (int t = 0; t < ntile; ++t) {
        const bool newt = (t == 32);
        const float* Kp = newt ? out + O_K_S + (size_t)(DECS * s) * DM + hv * 128 : a.in[I_CK] + ((size_t)s * PAST + ks * 1024 + t * 32) * DM + hv * 128;
        const float* Vp = newt ? out + O_V_S + (size_t)(DECS * s) * DM + h * 256 + dh * 128 : a.in[I_CV] + ((size_t)s * PAST + ks * 1024 + t * 32) * DM + h * 256 + dh * 128;
        f32x4 kf[8][2]; float vf[2][4][8];
        { const GAS float* kp = (const GAS float*)uni(Kp) + (size_t)r32 * DM + hi * 8;
#pragma unroll
          for (int d0 = 0; d0 < 8; ++d0) { kf[d0][0] = *(const GAS f32x4*)(kp + d0 * 16); kf[d0][1] = *(const GAS f32x4*)(kp + d0 * 16 + 4); }
          const GAS float* vp = (const GAS float*)uni(Vp) + (size_t)(8 * hi) * DM + r32;
#pragma unroll
          for (int k4 = 0; k4 < 2; ++k4)
#pragma unroll
              for (int d0 = 0; d0 < 4; ++d0)
#pragma unroll
                  for (int i = 0; i < 8; ++i) vf[k4][d0][i] = vp[(size_t)(16 * k4 + i) * DM + d0 * 32]; }
        f32x16 p0 = {};
#pragma unroll
        for (int d0 = 0; d0 < 8; ++d0) { const bf16x8 qf = *(const LAS bf16x8*)(qrow + d0 * 16);
            p0 = __builtin_amdgcn_mfma_f32_32x32x16_bf16(pack8(kf[d0][0], kf[d0][1]), qf, p0, 0, 0, 0); }
        float pmax = p0[0];
#pragma unroll
        for (int r = 1; r < 16; ++r) pmax = fmaxf(pmax, p0[r]);
        { auto rr = __builtin_amdgcn_permlane32_swap(__float_as_uint(pmax), __float_as_uint(pmax), false, false); pmax = fmaxf(__uint_as_float(rr[0]), __uint_as_float(rr[1])); }
        float alpha = 1.f;
        if (!__all((pmax - m_reg) * SCALE <= THR)) { const float mn = fmaxf(m_reg, pmax); alpha = __builtin_amdgcn_exp2f((m_reg - mn) * C2); m_reg = mn; }
        const float mnL = -m_reg * C2; float ps = 0.f;
#pragma unroll
        for (int r = 0; r < 16; ++r) { p0[r] = __builtin_amdgcn_exp2f(fmaf(p0[r], C2, mnL)); ps += p0[r]; }
        { auto rr = __builtin_amdgcn_permlane32_swap(__float_as_uint(ps), __float_as_uint(ps), false, false); ps = __uint_as_float(rr[0]) + __uint_as_float(rr[1]); }
        l_reg = l_reg * alpha + ps;
        bf16x8 pa[2];
#pragma unroll
        for (int k4 = 0; k4 < 2; ++k4) { const unsigned a0 = cvtpk(p0[8 * k4 + 0], p0[8 * k4 + 1]), a1 = cvtpk(p0[8 * k4 + 2], p0[8 * k4 + 3]), b0 = cvtpk(p0[8 * k4 + 4], p0[8 * k4 + 5]), b1 = cvtpk(p0[8 * k4 + 6], p0[8 * k4 + 7]);
            auto r0 = __builtin_amdgcn_permlane32_swap(a0, b0, false, false); auto r1 = __builtin_amdgcn_permlane32_swap(a1, b1, false, false);
            v4u w = {r0[0], r1[0], r0[1], r1[1]}; pa[k4] = __builtin_bit_cast(bf16x8, w); }
        if (__any(alpha < 1.f)) { LAS float* al = FAC + wid * 32; if (hi == 0) al[r32] = alpha; asm volatile("s_waitcnt lgkmcnt(0)" ::: "memory");
#pragma unroll
            for (int d_ = 0; d_ < 4; ++d_)
#pragma unroll
                for (int r = 0; r < 16; ++r) o[d_][r] *= al[crow(r, hi)];
            asm volatile("s_waitcnt lgkmcnt(0)" ::: "memory"); }
#pragma unroll
        for (int k4 = 0; k4 < 2; ++k4)
#pragma unroll
            for (int d0 = 0; d0 < 4; ++d0) { const f32x4 lo = {vf[k4][d0][0], vf[k4][d0][1], vf[k4][d0][2], vf[k4][d0][3]}, hi4 = {vf[k4][d0][4], vf[k4][d0][5], vf[k4][d0][6], vf[k4][d0][7]};
                o[d0] = __builtin_amdgcn_mfma_f32_32x32x16_bf16(pa[k4], pack8(lo, hi4), o[d0], 0, 0, 0); }
    }
    if (hi == 0) { ML[(wid * 32 + r32) * 2] = m_reg; ML[(wid * 32 + r32) * 2 + 1] = l_reg; }
    LDS_WAIT(); __syncthreads();
    { const float mp = ML[((wid ^ 1) * 32 + r32) * 2], lp = ML[((wid ^ 1) * 32 + r32) * 2 + 1];
      const float mt = fmaxf(m_reg, mp), fs = __builtin_amdgcn_exp2f((m_reg - mt) * C2), fp = __builtin_amdgcn_exp2f((mp - mt) * C2), lt = l_reg * fs + lp * fp;
      if (hi == 0) FAC[wid * 32 + r32] = fs * __builtin_amdgcn_rcpf(lt); }
    LDS_WAIT();
#pragma unroll
    for (int d0 = 0; d0 < 4; ++d0)
#pragma unroll
        for (int r = 0; r < 16; ++r) o[d0][r] *= FAC[wid * 32 + crow(r, hi)];
    LAS float* ob = OBUF + (size_t)(mj * 2 + dh) * 32 * 128;
    if (ks == 1) {
#pragma unroll
        for (int d0 = 0; d0 < 4; ++d0)
#pragma unroll
            for (int r = 0; r < 16; ++r) ob[crow(r, hi) * 128 + d0 * 32 + r32] = o[d0][r]; }
    LDS_WAIT(); __syncthreads();
    if (ks == 0) {
#pragma unroll
        for (int d0 = 0; d0 < 4; ++d0)
#pragma unroll
            for (int r = 0; r < 16; ++r) o[d0][r] += ob[crow(r, hi) * 128 + d0 * 32 + r32]; }
    LDS_WAIT(); __syncthreads();
    if (ks == 0 && mj == 1) {
#pragma unroll
        for (int d0 = 0; d0 < 4; ++d0)
#pragma unroll
            for (int r = 0; r < 16; ++r) OBUF[(size_t)dh * 32 * 128 + crow(r, hi) * 128 + d0 * 32 + r32] = o[d0][r]; }
    LDS_WAIT(); __syncthreads();
    float ssp[16];
#pragma unroll
    for (int r = 0; r < 16; ++r) ssp[r] = 0.f;
    if (ks == 0 && mj == 0) {
#pragma unroll
        for (int d0 = 0; d0 < 4; ++d0)
#pragma unroll
            for (int r = 0; r < 16; ++r) { const float x = o[d0][r] - lam * OBUF[(size_t)dh * 32 * 128 + crow(r, hi) * 128 + d0 * 32 + r32]; o[d0][r] = x; ssp[r] += x * x; }
#pragma unroll
        for (int r = 0; r < 16; ++r) { float q = ssp[r]; q += __shfl_xor(q, 1); q += __shfl_xor(q, 2); q += __shfl_xor(q, 4); q += __shfl_xor(q, 8); q += __shfl_xor(q, 16);
            if (r32 == 0) SSQ[dh * 32 + crow(r, hi)] = q; } }
    LDS_WAIT(); __syncthreads();
    if (ks == 0 && mj == 0) {
        bf16* Ow = OB + (size_t)(MP + DECS * s) * DM + h * 256 + dh * 128;
#pragma unroll
        for (int r = 0; r < 16; ++r) { const int row = crow(r, hi); ssp[r] = __builtin_amdgcn_rsqf((SSQ[row] + SSQ[32 + row]) * (1.0f / 256.0f) + EPS) * (1.0f - LAMBDA_INIT); }
#pragma unroll
        for (int d0 = 0; d0 < 4; ++d0) { const float g = a.in[I_ATSUBLN][dh * 128 + d0 * 32 + r32];
#pragma unroll
            for (int r = 0; r < 16; ++r) { const float v = o[d0][r] * ssp[r] * g; const float vn = __shfl_xor(v, 1);
                if ((r32 & 1) == 0) *(unsigned*)(Ow + (size_t)crow(r, hi) * DM + d0 * 32 + r32) = cvtpk(v, vn); } } }
    LDS_WAIT(); __syncthreads();
}
#undef ROW
#undef VMW
#undef VMWN
#undef LD8
}

__device__ __forceinline__ void attn_phase(const Ctx& F, const Args& a) {
    const bf16* Qb = (const bf16*)(F.ws + WS_Q); const bf16* Kb = (const bf16*)(F.ws + WS_K); const bf16* Vb = (const bf16*)(F.ws + WS_V); bf16* OB = (bf16*)(F.ws + WS_OB); float* stash = (float*)(F.ws + WS_ST);
    const int lane = opaque_tid() & 63;
    float lam;
    { const float* L = a.in[I_ATLAM]; const float s1 = wave_sum(L[lane] * L[128 + lane] + L[64 + lane] * L[192 + lane]), s2 = wave_sum(L[256 + lane] * L[384 + lane] + L[320 + lane] * L[448 + lane]);
      lam = __expf(s1) - __expf(s2) + LAMBDA_INIT; }
    unsigned* qctr = (unsigned*)(F.ws + WS_CTL) + CW_ATTNQ;
    volatile LAS int* qslot = (volatile LAS int*)(F.lds + MISC_OFF) + 16;
    const int tid0 = opaque_tid();
    for (;;) {
        if (tid0 == 0) *qslot = (int)__hip_atomic_fetch_add(qctr, 1u, __ATOMIC_RELAXED, __HIP_MEMORY_SCOPE_AGENT);
        __syncthreads();
        const int idx = __builtin_amdgcn_readfirstlane(*qslot);
        __syncthreads();
        if (idx >= 1152) break;
        if (idx >= 640 && idx < 768) { const int u = idx - 640; att::sample_unit(F.lds, u >> 3, u & 7, a, Qb, F.out, OB, lam); continue; }
        const int j = idx < 640 ? idx : idx - 128, qb = 7 - (j >> 7), bh = j & 127, b = bh >> 3, h = bh & 7;
#pragma unroll 1
        for (int m1 = 0; m1 < 2; ++m1) { const int hv = 2 * h + (m1 ? 0 : 1);
            att::BlockRef r; r.Q = Qb + (size_t)(b * SEQ + qb * att::QB) * DM + hv * 128; r.K = Kb + (size_t)(b * SEQ) * DM + hv * 128; r.V = Vb + (size_t)(b * SEQ) * DM + h * 256;
            r.P0 = qb * att::QB; r.mode = m1; r.orow = b * SEQ + qb * att::QB; r.h = h;
            att::block2(r, F.lds, lam, a.in[I_ATSUBLN], stash, OB); }
    }
    VM_WAIT(); __syncthreads();
}

#ifndef MK_PH_LO
#define MK_PH_LO 0
#endif
#ifndef MK_PH_HI
#define MK_PH_HI 99
#endif
template <class Epi>
__device__ __forceinline__ void run_gemm(const Ctx& F, const bf16* A, const bf16* Bt, int N, int K, const Epi& E, int M = MT) {
    pg8::Gemm g{A, Bt, M, N, K, K}; pg8::StaticOrder S; S.init(M, N, F.G, (int)blockIdx.x);
    pg8::gemm_phase<Epi, pg8::StaticOrder, PG8_ALIGN, PG8_SP2>(F.lds + RING_OFF, g, S, E);
}
__device__ __forceinline__ void run_resid_gemm(const Ctx& F, const bf16* A, const bf16* Bt, int K, int f, const EpiResid& E) {
    run_gemm(F, A, Bt, DM, K, E, MP);
    const int kc = K / f;
    pg8::Gemm g{A, Bt, MT, DM, kc, K}; pg8::SplitOrder S; S.init(MP / 256, DM, f, kc, F.G, (int)blockIdx.x);
    EpiSlab ES{(float*)(F.ws + WS_SLAB), kc};
    pg8::gemm_phase<EpiSlab, pg8::SplitOrder, PG8_ALIGN, PG8_SP2>(F.lds + RING_OFF, g, S, ES);
}
__device__ __forceinline__ void ffn_layer(const Ctx& F, const Args& a, const XcdBarrier& bar, int layer, const float* ss_in, float* ss_out) {
    bf16* XB = (bf16*)(F.ws + WS_XB); bf16* H = (bf16*)(F.ws + WS_H); float* UE = (float*)(F.ws + WS_UE);
    { EpiFfnUp E{H, UE, ss_in + RS_OFF, a.in[I_FFNCW] + (size_t)layer * 3 * NUP, a.in[I_FFNCB] + (size_t)layer * NUP};
      run_gemm(F, XB, (const bf16*)(F.ws + (layer ? WS_UP1 : WS_UP0)), NUP, DM, E); }
    xcd_barrier(bar);
    ffn_fixup(F, a, layer);
    xcd_barrier(bar);
    { EpiResid E{F.out, F.out + (size_t)MP * DM, F.out, XB, ss_out};
      run_resid_gemm(F, H, (const bf16*)(F.ws + (layer ? WS_DN1 : WS_DN0)), DFF, 11, E); }
    xcd_barrier(bar);
    resid_finish(F, F.out + (size_t)MP * DM, 11, ss_out);
    xcd_barrier(bar);
}
__global__ void __launch_bounds__(NWAVES * 64, 2) mk_fwd(Args args) {
    extern __shared__ __attribute__((aligned(16))) unsigned char lds_raw[];
    Ctx F;
    F.lds = (LAS unsigned char*)lds_raw; F.ws = args.ws; F.out = args.out;
    F.G = gridDim.x; { const int bx = blockIdx.x; F.vcu = (F.G % 8 == 0) ? (bx % 8) * (F.G / 8) + bx / 8 : bx; }
    volatile LAS unsigned* MISC = (volatile LAS unsigned*)(F.lds + MISC_OFF);
    for (int u = threadIdx.x; u < (LDS_BYTES - LDSCTL_OFF) / 4; u += NWAVES * 64) ((LAS unsigned*)(F.lds + LDSCTL_OFF))[u] = 0u;
    __syncthreads();
    XcdBarrier bar = xcd_barrier_post((unsigned*)(F.ws + WS_CTL) + CW_BAR, MISC + 8);
    bf16* XB = (bf16*)(F.ws + WS_XB);
    float* SS0 = (float*)(F.ws + WS_SS), *SS1 = (float*)(F.ws + WS_SS + SS_STRIDE), *SS2 = (float*)(F.ws + WS_SS + 2 * SS_STRIDE), *SS3 = (float*)(F.ws + WS_SS + 3 * SS_STRIDE), *SS4 = (float*)(F.ws + WS_SS + 4 * SS_STRIDE);

#ifndef PHM
#define PHM 0xffff
#endif
#ifndef REP_P0
#define REP_P0 1
#endif
#ifndef REP_P2
#define REP_P2 1
#endif
#ifndef REP_P7
#define REP_P7 1
#endif
    for (int rep = 0; rep < REP_P0; ++rep) { if (rep) { VM_WAIT(); __syncthreads(); } p0_prologue(F, args); }
    xcd_barrier(bar);
#ifndef REP_P1
#define REP_P1 1
#endif
    for (int rep = 0; rep < REP_P1; ++rep) { if (rep) { VM_WAIT(); __syncthreads(); } EpiWin E{(bf16*)(F.ws + WS_U), SS0 + RS_OFF}; run_gemm(F, XB, (const bf16*)(F.ws + WS_WIN), 4096, DM, E); }
    xcd_barrier(bar);
    for (int rep = 0; rep < REP_P2; ++rep) { if (rep) { VM_WAIT(); __syncthreads(); } rglru_phase(F, args); }
    xcd_barrier(bar);
    if constexpr (PHM & 8) { EpiResid E{args.in[I_XP], args.in[I_XS], F.out, XB, SS1}; run_resid_gemm(F, (const bf16*)(F.ws + WS_HY), (const bf16*)(F.ws + WS_RGO), DM, 8, E); }
    xcd_barrier(bar);
    resid_finish(F, args.in[I_XS], 8, SS1);
    xcd_barrier(bar);
    if constexpr (PHM & 16) ffn_layer(F, args, bar, 0, SS1, SS2);
    if constexpr (PHM & 32) { EpiQkv E{(bf16*)(F.ws + WS_Q), (bf16*)(F.ws + WS_K), (bf16*)(F.ws + WS_V), F.out, SS2 + RS_OFF}; run_gemm(F, XB, (const bf16*)(F.ws + WS_QKV), NQKV, DM, E); }
    xcd_barrier(bar);
    for (int rep = 0; rep < REP_P7; ++rep) { if (rep) { VM_WAIT(); __syncthreads(); } attn_phase(F, args); }
    xcd_barrier(bar);
    if constexpr (PHM & 128) { EpiResid E{F.out, F.out + (size_t)MP * DM, F.out, XB, SS3}; run_resid_gemm(F, (const bf16*)(F.ws + WS_OB), (const bf16*)(F.ws + WS_ATO), DM, 8, E); }
    xcd_barrier(bar);
    resid_finish(F, F.out + (size_t)MP * DM, 8, SS3);
    xcd_barrier(bar);
    if constexpr (PHM & 256) ffn_layer(F, args, bar, 1, SS3, SS4);
    if constexpr (PHM & 512) final_norm(F, args, SS4);
}

extern "C" void kernel_launch(void* const* d_in, const int* in_sizes, int n_in, void* d_out, int out_size, void* d_ws, size_t ws_size, hipStream_t stream) {
    static int grid = 0;
    if (grid == 0) {
        if (n_in != 26 || in_sizes[0] != MP * DM || (size_t)out_size != O_END || ws_size < WS_END) {
            fprintf(stderr, "kernel_launch: shape mismatch (n_in %d, in0 %d, out %d, ws %zu; need ws >= %zu); nothing launched\n", n_in, n_in > 0 ? in_sizes[0] : -1, out_size, ws_size, (size_t)WS_END); grid = -1; return; }
        int dev = 0, cus = 0, per_cu = 0;
        if (hipGetDevice(&dev) != hipSuccess || hipDeviceGetAttribute(&cus, hipDeviceAttributeMultiprocessorCount, dev) != hipSuccess) { fprintf(stderr, "kernel_launch: device query failed\n"); grid = -1; return; }
        if (hipFuncSetAttribute((const void*)mk_fwd, hipFuncAttributeMaxDynamicSharedMemorySize, LDS_BYTES) != hipSuccess) { fprintf(stderr, "kernel_launch: hipFuncSetAttribute failed\n"); grid = -1; return; }
        if (hipOccupancyMaxActiveBlocksPerMultiprocessor(&per_cu, (const void*)mk_fwd, NWAVES * 64, LDS_BYTES) != hipSuccess || per_cu < 1)
            fprintf(stderr, "kernel_launch: note: occupancy query reports %d workgroups per CU\n", per_cu);
        (void)hipGetLastError();
        grid = cus;
    }
    if (grid < 0) return;
    if (hipMemsetAsync((char*)d_ws + WS_CTL, 0, CTL_ZERO_BYTES, stream) != hipSuccess) { fprintf(stderr, "kernel_launch: memset failed\n"); return; }
    Args a{};
    for (int i = 0; i < 26; ++i) a.in[i] = (const float*)d_in[i];
    a.out = (float*)d_out; a.ws = (unsigned char*)d_ws;
    hipLaunchKernelGGL(mk_fwd, dim3(grid), dim3(NWAVES * 64), LDS_BYTES, stream, a);
    const hipError_t le = hipPeekAtLastError();
    if (le != hipSuccess) fprintf(stderr, "kernel_launch: launch failed: %s\n", hipGetErrorName(le));
}
```
